# Optimizing an MI355X kernel written in HIP

```python
import jax, jax.numpy as jnp
from jax import lax
import numpy as np

D_MODEL = 1024
BATCH = 4
SEQ = 4096
DEPTH = 2

GRID_W = 64
CTX_LEN = 256
D_A = D_MODEL
SGU_GROUPS = 8
SGU_GROUP_DIM = D_A // SGU_GROUPS
SGU_CHUNK = 128
D_B = D_MODEL
HGRN_HEAD_DIM = 128
HGRN_HEADS = D_B // HGRN_HEAD_DIM
HGRN_CHUNK = 64
D_FF = 2816
CONV_W = 3
N_MOD = 6
RMS_EPS = 1e-6
LN_EPS = 1e-5
IN_SPLITS = (D_B, 2 * D_B, 3 * D_B, 4 * D_B, 4 * D_B + D_A, 4 * D_B + 2 * D_A, 5 * D_B + 2 * D_A, 5 * D_B + 2 * D_A + D_MODEL)
D_IN = 5 * D_B + 2 * D_A + 2 * D_MODEL

kernel_name = 'hybrid_sgu_hgrn2_convffn_prefix_dit'


def rms_norm(x, w):
    xf = x.astype(jnp.float32)
    y = xf * lax.rsqrt(jnp.mean(xf * xf, axis=-1, keepdims=True) + RMS_EPS)
    return (y * w.astype(jnp.float32)).astype(x.dtype)


def layer_norm(x, w, b):
    xf = x.astype(jnp.float32)
    mu = jnp.mean(xf, axis=-1, keepdims=True)
    var = jnp.mean(jnp.square(xf - mu), axis=-1, keepdims=True)
    y = (xf - mu) * lax.rsqrt(var + LN_EPS)
    return (y * w.astype(jnp.float32) + b.astype(jnp.float32)).astype(x.dtype)


def modulate(h, shift, scale):
    return h * (1 + scale) + shift


def to_heads(t):
    bsz, length, _ = t.shape
    return t.reshape(bsz, length, HGRN_HEADS, HGRN_HEAD_DIM).transpose(0, 2, 1, 3)


def hgrn_forget(f_logit, lb):
    z = f_logit.astype(jnp.float32)
    f = lb + (1 - lb) * jax.nn.sigmoid(z)
    return to_heads((1 - lb) * jax.nn.sigmoid(-z)), to_heads(jnp.log(f))


def gla_chunked(q, k, v, g, s0):
    bsz, heads, length, _ = q.shape
    n = length // HGRN_CHUNK
    split = lambda t: t.reshape(bsz, heads, n, HGRN_CHUNK, t.shape[-1])
    q, k, v, g = split(q), split(k), split(v), split(g)
    b = jnp.cumsum(g, axis=3)
    b_last = b[:, :, :, -1:, :]
    ref = b[:, :, :, HGRN_CHUNK // 2 - 1:HGRN_CHUNK // 2, :]
    scores = jnp.einsum('bhntk,bhnsk->bhnts', q * jnp.exp(b - ref), k * jnp.exp(ref - b))
    lower = jnp.tril(jnp.ones((HGRN_CHUNK, HGRN_CHUNK), dtype=bool))
    o_intra = jnp.einsum('bhnts,bhnsv->bhntv', jnp.where(lower, scores, 0.0), v)
    q_inter = q * jnp.exp(b)
    kv = jnp.einsum('bhnsk,bhnsv->bhnkv', k * jnp.exp(b_last - b), v)
    decay = jnp.exp(b_last[:, :, :, 0, :])

    def step(state, xs):
        q_n, kv_n, d_n = xs
        o_n = jnp.einsum('bhtk,bhkv->bhtv', q_n, state)
        return d_n[..., None] * state + kv_n, o_n

    move = lambda t: jnp.moveaxis(t, 2, 0)
    s_final, o_inter = lax.scan(step, s0, (move(q_inter), move(kv), move(decay)))
    o = o_intra + jnp.moveaxis(o_inter, 0, 2)
    return o.reshape(bsz, heads, length, -1), s_final


def hgrn_bidir(q, f_fwd, f_bwd, i, lb_fwd, lb_bwd, s0_fwd, s0_bwd):
    qh = to_heads(jax.nn.silu(q.astype(jnp.float32)))
    ih = to_heads(i.astype(jnp.float32))
    k_f, g_f = hgrn_forget(f_fwd, lb_fwd)
    k_b, g_b = hgrn_forget(f_bwd, lb_bwd)
    o_f, s_f = gla_chunked(qh, k_f, ih, g_f, s0_fwd)
    rev = lambda t: jnp.flip(t, axis=2)
    o_b, s_b = gla_chunked(rev(qh), rev(k_b), rev(ih), rev(g_b), s0_bwd)
    return o_f + rev(o_b), s_f, s_b


def hgrn_readout(o, og, norm_w):
    o = o * lax.rsqrt(jnp.mean(o * o, axis=-1, keepdims=True) + RMS_EPS) * norm_w.astype(jnp.float32)
    bsz, _, length, _ = o.shape
    o = o.transpose(0, 2, 1, 3).reshape(bsz, length, D_B).astype(og.dtype)
    return o * jax.nn.silu(og)


def sgu(u, v, ln_w, ln_b, w_s, b_s):
    bsz, length, _ = v.shape
    vn = layer_norm(v, ln_w, ln_b).reshape(bsz, length // SGU_CHUNK, SGU_CHUNK, SGU_GROUPS, SGU_GROUP_DIM)
    mixed = jnp.einsum('gts,bnsgd->bntgd', w_s, vn) + b_s.T[:, :, None]
    return u * mixed.reshape(bsz, length, D_A)


def token_mixer_out(parts, o_b, sgu_ln_w, sgu_ln_b, sgu_w, sgu_b, hgrn_norm_w, w_a, w_b, w_o):
    u, v, og, gate_a, gate_b = parts
    y_a = sgu(jax.nn.gelu(u), jax.nn.gelu(v), sgu_ln_w, sgu_ln_b, sgu_w, sgu_b)
    y_b = hgrn_readout(o_b, og, hgrn_norm_w)
    merged = jax.nn.sigmoid(gate_a) * (y_a @ w_a) + jax.nn.sigmoid(gate_b) * (y_b @ w_b)
    return merged @ w_o


def dwconv_grid(a, conv_w, conv_b):
    bsz, length, ch = a.shape
    rows = length // GRID_W
    y = lax.conv_general_dilated(a.reshape(bsz, rows, GRID_W, ch), conv_w[:, :, None, :].astype(a.dtype),
                                 window_strides=(1, 1), padding='SAME',
                                 dimension_numbers=('NHWC', 'HWIO', 'NHWC'), feature_group_count=ch)
    return y.reshape(bsz, length, ch) + conv_b


def dwconv_seq(a, conv_w, conv_b):
    y = lax.conv_general_dilated(a, conv_w[CONV_W // 2][:, None, :].astype(a.dtype),
                                 window_strides=(1,), padding='SAME',
                                 dimension_numbers=('NWC', 'WIO', 'NWC'), feature_group_count=a.shape[-1])
    return y + conv_b


def conv_ffn(h, w_up, conv_w, conv_b, w_down, on_grid):
    a, v = jnp.split(h @ w_up, 2, axis=-1)
    a = dwconv_grid(a, conv_w, conv_b) if on_grid else dwconv_seq(a, conv_w, conv_b)
    return (jax.nn.gelu(a) * v) @ w_down


def setup_inputs(seed: int = 0) -> dict:
    key = jax.random.key(seed)
    ks = jax.random.split(key, 24)
    nrm = lambda k, shape, s: s * jax.random.normal(k, shape, jnp.float32)
    gain = lambda k, shape: 1.0 + nrm(k, shape, 0.02)
    return {
        'x': nrm(ks[0], (BATCH, SEQ, D_MODEL), 1.0),
        'c': nrm(ks[1], (BATCH, D_MODEL), 1.0),
        'ctx': nrm(ks[2], (BATCH, CTX_LEN, D_MODEL), 1.0),
        'c_ctx': nrm(ks[3], (D_MODEL,), 1.0),
        'ada_w': nrm(ks[4], (DEPTH, D_MODEL, N_MOD * D_MODEL), 0.5 * D_MODEL ** -0.5),
        'ada_b': nrm(ks[5], (DEPTH, N_MOD * D_MODEL), 0.02),
        'norm1_w': gain(ks[6], (DEPTH, D_MODEL)),
        'w_in': nrm(ks[7], (DEPTH, D_MODEL, D_IN), D_MODEL ** -0.5),
        'sgu_ln_w': gain(ks[8], (DEPTH, D_A)),
        'sgu_ln_b': nrm(ks[9], (DEPTH, D_A), 0.02),
        'sgu_w': nrm(ks[10], (DEPTH, SGU_GROUPS, SGU_CHUNK, SGU_CHUNK), SGU_CHUNK ** -0.5),
        'sgu_b': gain(ks[11], (DEPTH, SGU_GROUPS, SGU_CHUNK)),
        'hgrn_lower_bounds': nrm(ks[12], (DEPTH, 2 * D_B), 0.1),
        'hgrn_norm_w': gain(ks[13], (DEPTH, HGRN_HEAD_DIM)),
        'w_branch_a': nrm(ks[14], (DEPTH, D_A, D_MODEL), D_A ** -0.5),
        'w_branch_b': nrm(ks[15], (DEPTH, D_B, D_MODEL), D_B ** -0.5),
        'w_out': nrm(ks[16], (DEPTH, D_MODEL, D_MODEL), D_MODEL ** -0.5),
        'norm2_w': gain(ks[17], (DEPTH, D_MODEL)),
        'ffn_w_up': nrm(ks[18], (DEPTH, D_MODEL, 2 * D_FF), D_MODEL ** -0.5),
        'ffn_conv_w': nrm(ks[19], (DEPTH, CONV_W, CONV_W, D_FF), 1.0 / CONV_W),
        'ffn_conv_b': nrm(ks[20], (DEPTH, D_FF), 0.02),
        'ffn_w_down': nrm(ks[21], (DEPTH, D_FF, D_MODEL), D_FF ** -0.5),
        'final_norm_w': gain(ks[22], (D_MODEL,)),
    }


def reference(x, c, ctx, c_ctx, ada_w, ada_b, norm1_w, w_in, sgu_ln_w, sgu_ln_b, sgu_w, sgu_b,
              hgrn_lower_bounds, hgrn_norm_w, w_branch_a, w_branch_b, w_out, norm2_w,
              ffn_w_up, ffn_conv_w, ffn_conv_b, ffn_w_down, final_norm_w):
    lb = jax.nn.softmax(hgrn_lower_bounds.astype(jnp.float32), axis=0)
    lb = jnp.cumsum(lb, axis=0) - lb[0]
    zero_state = jnp.zeros((ctx.shape[0], HGRN_HEADS, HGRN_HEAD_DIM, HGRN_HEAD_DIM), jnp.float32)
    for l in range(DEPTH):
        last = l == DEPTH - 1
        mod_x = (jax.nn.silu(c) @ ada_w[l] + ada_b[l])[:, None, :]
        mod_c = jax.nn.silu(c_ctx) @ ada_w[l] + ada_b[l]
        sh1, sc1, g1, sh2, sc2, g2 = jnp.split(mod_x, N_MOD, axis=-1)
        csh1, csc1, cg1, csh2, csc2, cg2 = jnp.split(mod_c, N_MOD, axis=-1)
        lb_f, lb_b = lb[l, :D_B], lb[l, D_B:]

        h_c = modulate(rms_norm(ctx, norm1_w[l]), csh1, csc1)
        n_cols = IN_SPLITS[3] if last else D_IN
        parts_c = jnp.split(h_c @ w_in[l, :, :n_cols], IN_SPLITS[:3] if last else IN_SPLITS, axis=-1)
        o_c, s_f, s_b = hgrn_bidir(*parts_c[:4], lb_f, lb_b, zero_state, zero_state)

        h_x = modulate(rms_norm(x, norm1_w[l]), sh1, sc1)
        parts_x = jnp.split(h_x @ w_in[l], IN_SPLITS, axis=-1)
        o_x, _, _ = hgrn_bidir(*parts_x[:4], lb_f, lb_b, s_f, s_b)
        x = x + g1 * token_mixer_out(parts_x[4:], o_x, sgu_ln_w[l], sgu_ln_b[l], sgu_w[l], sgu_b[l],
                                     hgrn_norm_w[l], w_branch_a[l], w_branch_b[l], w_out[l])
        h2 = modulate(rms_norm(x, norm2_w[l]), sh2, sc2)
        x = x + g2 * conv_ffn(h2, ffn_w_up[l], ffn_conv_w[l], ffn_conv_b[l], ffn_w_down[l], True)

        if not last:
            ctx = ctx + cg1 * token_mixer_out(parts_c[4:], o_c, sgu_ln_w[l], sgu_ln_b[l], sgu_w[l], sgu_b[l],
                                              hgrn_norm_w[l], w_branch_a[l], w_branch_b[l], w_out[l])
            hc2 = modulate(rms_norm(ctx, norm2_w[l]), csh2, csc2)
            ctx = ctx + cg2 * conv_ffn(hc2, ffn_w_up[l], ffn_conv_w[l], ffn_conv_b[l], ffn_w_down[l], False)
    return rms_norm(x, final_norm_w)
```

```cpp
#include <hip/hip_runtime.h>
#include <hip/hip_cooperative_groups.h>
#include <cstdio>
namespace cg = cooperative_groups;

constexpr int DM = 1024, NBATCH = 4, SEQL = 4096, CTXL = 256, RL = NBATCH * SEQL, RC = NBATCH * CTXL, RT = RL + RC;
constexpr int DIN = 9216, DFF = 2816;
constexpr size_t USLOT = (size_t)RT * 1024 * 2;
constexpr size_t WS_WIN = 0;
constexpr size_t WS_WA = WS_WIN + (size_t)DIN * 1024 * 2;
constexpr size_t WS_WB = WS_WA + 1024 * 1024 * 2;
constexpr size_t WS_WO = WS_WB + 1024 * 1024 * 2;
constexpr size_t WS_WUP = WS_WO + 1024 * 1024 * 2;
constexpr size_t WS_WDN = WS_WUP + (size_t)2 * DFF * 1024 * 2;
constexpr size_t WS_WS = WS_WDN + (size_t)1024 * DFF * 2;
constexpr size_t WS_MOD = WS_WS + 8 * 128 * 128 * 2;
constexpr size_t WS_LB = WS_MOD + 2 * 5 * 6144 * 4;
constexpr size_t WS_CTX = WS_LB + 2 * 2048 * 4;
constexpr size_t WS_ACT = WS_CTX + (size_t)RC * 1024 * 4;
constexpr size_t WS_BAR = WS_ACT + 7 * USLOT;
constexpr size_t WS_VEC = WS_BAR + 16384;
constexpr size_t WS_STAT = WS_VEC + (size_t)272 * 8 * 2 * 256 * 4;
constexpr size_t WS_END = WS_STAT + (size_t)RT * 2 * 4;
constexpr int LDS_BYTES = 137744;

#define DI __device__ __forceinline__
DI float bf2f(unsigned short u) { return __uint_as_float((unsigned)u << 16); }
DI float bflo(unsigned w) { return __uint_as_float(w << 16); }
DI float bfhi(unsigned w) { return __uint_as_float(w & 0xffff0000u); }
DI unsigned short f2bf(float f) { unsigned u = __float_as_uint(f); u += 0x7fffu + ((u >> 16) & 1u); return (unsigned short)(u >> 16); }
typedef __bf16 bf16v2_t __attribute__((ext_vector_type(2))); typedef float f32v2_t __attribute__((ext_vector_type(2)));
DI unsigned pk2(float lo, float hi) { const f32v2_t f = {lo, hi}; const bf16v2_t h = __builtin_convertvector(f, bf16v2_t); return __builtin_bit_cast(unsigned, h); }
DI unsigned pkh2(float a, float b) { _Float16 x = (_Float16)a, y = (_Float16)b; return (unsigned)__builtin_bit_cast(unsigned short, x) | ((unsigned)__builtin_bit_cast(unsigned short, y) << 16); }
DI float h2f(unsigned short u) { return (float)__builtin_bit_cast(_Float16, u); }
DI float fexp(float x) { return __builtin_amdgcn_exp2f(x * 1.44269504089f); }
DI float flog(float x) { return __builtin_amdgcn_logf(x) * 0.69314718056f; }
DI float sigm(float x) { return __builtin_amdgcn_rcpf(1.0f + fexp(-x)); }
DI float silu_f(float x) { return x * sigm(x); }
DI float gelu_t(float x) { return x * sigm(1.59576912161f * (x + 0.044715f * x * x * x)); }
DI float wave_sum(float v) { for (int o = 32; o >= 1; o >>= 1) v += __shfl_xor(v, o); return v; }

namespace pg8 {
#define PG8_LAS __attribute__((address_space(3)))
typedef unsigned short bf16_t;
typedef short bf16x8 __attribute__((ext_vector_type(8)));
typedef float f32x4 __attribute__((ext_vector_type(4)));
typedef unsigned u32x4 __attribute__((ext_vector_type(4)));
constexpr int BM = 256, BK = 64, HALF = 128, HTB = HALF * BK * 2  , STAGE_BYTES = 8 * HTB, NXCD = 8, WGM = 8;

__host__ __device__ __forceinline__ int lds_byte(int r, int c) { const int st = (r >> 4) * 2 + (c >> 5), rr = r & 15, cc = c & 31, ob = rr * 64 + cc * 2; return st * 1024 + (ob ^ (((ob >> 9) & 1) << 5)); }
__host__ __device__ __forceinline__ void stage_rc(int b, int& R, int& C) { const int st = b / 1024, sb = b % 1024, swz = sb ^ (((sb >> 9) & 1) << 5); R = (st >> 1) * 16 + swz / 64; C = (st & 1) * 32 + (swz % 64) / 2; }
__host__ __device__ __forceinline__ int perm32(int rho) { const int n = rho >> 4, i = rho & 15; return 8 * (i >> 2) + 4 * n + (i & 3); }

struct Unit { int pm, pn; };
struct Gemm { const bf16_t* A; const bf16_t* Bt; int M, N, K; };

struct StaticOrder {
    int nM, nN, nwg, G, c;
    __host__ __device__ void init(int M, int N, int G_, int c_) { nM = M / BM; nN = N / BM; nwg = nM * nN; G = G_; c = c_; }
    __host__ __device__ bool next(int i, Unit& u) const {
        const long L = (long)i * G + c; if (L >= nwg) return false;
        int wgid = (int)L; { const int q = nwg / NXCD, r = nwg % NXCD, xcd = wgid % NXCD, off = wgid / NXCD; wgid = (xcd < r ? xcd * (q + 1) : r * (q + 1) + (xcd - r) * q) + off; }
        const int nig = WGM * nN, gid = wgid / nig, fm = gid * WGM, gsz = (nM - fm) < WGM ? (nM - fm) : WGM;
        u.pm = fm + ((wgid % nig) % gsz); u.pn = (wgid % nig) / gsz; return true;
    }
    __device__ __forceinline__ void a_ready(const Unit&) const {}
    __device__ __forceinline__ void done(const Unit&) const {}
};
__device__ __forceinline__ unsigned cvt_pk_bf16(float lo, float hi) { unsigned r; asm volatile("v_cvt_pk_bf16_f32 %0, %1, %2" : "=v"(r) : "v"(lo), "v"(hi)); return r; }
typedef float f32x2 __attribute__((ext_vector_type(2)));
template <class Epi, class Sched, bool ALIGN_EPI = false, bool SP2 = false>
__device__ __forceinline__ void gemm_phase(PG8_LAS unsigned char* lds, const Gemm g, const Sched& S, const Epi& E) {
    int tid = threadIdx.x; asm volatile("" : "+v"(tid)); const int wid = __builtin_amdgcn_readfirstlane(tid >> 6), lane = tid & 63, wr = wid >> 2, wc = wid & 3, fr = lane & 15, fq = lane >> 4;
    const int K = g.K, nt = K / BK;
    unsigned voffA[2], voffB[2];
#pragma unroll
    for (int i = 0; i < 2; ++i) { int R, C; stage_rc(tid * 16 + i * 8192, R, C); const int Rb = Epi::PERM ? ((R & ~31) + perm32(R & 31)) : R;
        voffA[i] = (unsigned)(R * K + C) * 2u; voffB[i] = (unsigned)(Rb * K + C) * 2u; }
    const size_t kstep = (size_t)(BK * 2);
    const size_t hstep = (size_t)HALF * K * 2;
    const size_t tstep = 2 * hstep;
    const unsigned ldsw = (unsigned)wid * 1024u;
    const int aoff = lds_byte(wr * 64 + fr, fq * 8), boff = lds_byte(wc * 32 + fr, fq * 8);
#define PG8_SA(b, h) (((b) * 2 + (h)) * HTB)
#define PG8_SB(b, h) ((4 + (b) * 2 + (h)) * HTB)
#define PG8_STAGE(bufoff, gbase, voff) do { _Pragma("unroll") for (int _i = 0; _i < 2; ++_i) \
        __builtin_amdgcn_global_load_lds((const unsigned*)((const char*)(gbase) + (voff)[_i]), (PG8_LAS unsigned*)(lds + (bufoff) + ldsw + _i * 8192), 16, 0, 0); } while (0)
#define PG8_LDA(dst, b, h) do { _Pragma("unroll") for (int m = 0; m < 4; ++m) _Pragma("unroll") for (int k = 0; k < 2; ++k) dst[m][k] = *(const PG8_LAS bf16x8*)(lds + PG8_SA(b, h) + aoff + m * 2048 + k * 1024); } while (0)
#define PG8_LDB(dst, b, h) do { _Pragma("unroll") for (int n = 0; n < 2; ++n) _Pragma("unroll") for (int k = 0; k < 2; ++k) dst[n][k] = *(const PG8_LAS bf16x8*)(lds + PG8_SB(b, h) + boff + n * 2048 + k * 1024); } while (0)
#define PG8_MMA(ai, bj, At, Bt) do { __builtin_amdgcn_s_setprio(1); _Pragma("unroll") for (int m = 0; m < 4; ++m) _Pragma("unroll") for (int n = 0; n < 2; ++n) _Pragma("unroll") for (int k = 0; k < 2; ++k) \
        acc[ai][bj][m][n] = __builtin_amdgcn_mfma_f32_16x16x32_bf16(Bt[n][k], At[m][k], acc[ai][bj][m][n], 0, 0, 0); __builtin_amdgcn_s_setprio(0); } while (0)
#define PG8_WAIT_V(n) asm volatile("s_waitcnt vmcnt(" #n ")" ::: "memory")
#define PG8_WAIT_L(n) asm volatile("s_waitcnt lgkmcnt(" #n ")" ::: "memory")
#define PG8_BAR __builtin_amdgcn_s_barrier()
#define PG8_SCHED __builtin_amdgcn_sched_barrier(0)
    Unit cur, nxt; int ui = 0;
    if (!S.next(0, cur)) return;
    f32x4 acc[2][2][4][2];
#pragma unroll
    for (int a = 0; a < 2; ++a)
#pragma unroll
        for (int b = 0; b < 2; ++b)
#pragma unroll
            for (int m = 0; m < 4; ++m)
#pragma unroll
                for (int n = 0; n < 2; ++n) acc[a][b][m][n] = (f32x4){0.f, 0.f, 0.f, 0.f};
    bf16x8 At[4][2], B0[2][2], B1[2][2];
    const char* cA = (const char*)g.A + (size_t)cur.pm * tstep; const char* cB = (const char*)g.Bt + (size_t)cur.pn * tstep;
    S.a_ready(cur);
    if constexpr (SP2) {
        PG8_STAGE(PG8_SB(0, 0), cB, voffB); PG8_STAGE(PG8_SB(0, 1), cB + hstep, voffB); PG8_STAGE(PG8_SA(0, 0), cA, voffA); PG8_STAGE(PG8_SA(0, 1), cA + hstep, voffA);
        if (wr == 1) PG8_BAR;
        PG8_WAIT_V(2); PG8_BAR;
        PG8_STAGE(PG8_SB(1, 0), cB + kstep, voffB); PG8_STAGE(PG8_SA(1, 0), cA + kstep, voffA); PG8_STAGE(PG8_SB(1, 1), cB + hstep + kstep, voffB);
        PG8_WAIT_V(6); PG8_BAR;
    } else {
        PG8_STAGE(PG8_SB(0, 0), cB, voffB); PG8_STAGE(PG8_SA(0, 0), cA, voffA); PG8_STAGE(PG8_SB(0, 1), cB + hstep, voffB); PG8_STAGE(PG8_SA(0, 1), cA + hstep, voffA);
        if (wr == 1) PG8_BAR;
        PG8_WAIT_V(4); PG8_BAR;
        PG8_STAGE(PG8_SB(1, 0), cB + kstep, voffB); PG8_STAGE(PG8_SA(1, 0), cA + kstep, voffA); PG8_STAGE(PG8_SB(1, 1), cB + hstep + kstep, voffB);
        PG8_WAIT_V(6); PG8_BAR;
    }
    for (;;) {
        const bool has_next = S.next(ui + 1, nxt);
        const char* nA = has_next ? (const char*)g.A + (size_t)nxt.pm * tstep : cA; const char* nB = has_next ? (const char*)g.Bt + (size_t)nxt.pn * tstep : cB;
        for (int t = 0; t < nt; t += 2) {
            const bool last = (t == nt - 2);
            const char* a1 = cA + (size_t)(t + 1) * kstep;
            const char* a2 = last ? nA : cA + (size_t)(t + 2) * kstep; const char* b2 = last ? nB : cB + (size_t)(t + 2) * kstep;
            const char* a3 = a2 + kstep; const char* b3 = b2 + kstep;
            if (last && has_next) S.a_ready(nxt);
            if constexpr (SP2) {
            PG8_LDB(B0, 0, 0); PG8_LDB(B1, 0, 1); PG8_SCHED; PG8_LDA(At, 0, 0); PG8_STAGE(PG8_SA(1, 1), a1 + hstep, voffA);
            PG8_WAIT_V(8); PG8_WAIT_L(0); PG8_BAR; PG8_MMA(0, 0, At, B0); PG8_MMA(0, 1, At, B1); PG8_BAR; PG8_SCHED;
            PG8_LDA(At, 0, 1); PG8_STAGE(PG8_SB(0, 0), b2, voffB); PG8_STAGE(PG8_SB(0, 1), b2 + hstep, voffB); PG8_STAGE(PG8_SA(0, 0), a2, voffA);
            PG8_WAIT_V(8); PG8_WAIT_L(0); PG8_BAR; PG8_MMA(1, 0, At, B0); PG8_MMA(1, 1, At, B1); PG8_BAR; PG8_SCHED;
            PG8_LDB(B0, 1, 0); PG8_LDB(B1, 1, 1); PG8_SCHED; PG8_LDA(At, 1, 0); PG8_STAGE(PG8_SA(0, 1), a2 + hstep, voffA);
            PG8_WAIT_V(8); PG8_WAIT_L(0); PG8_BAR; PG8_MMA(0, 0, At, B0); PG8_MMA(0, 1, At, B1); PG8_BAR; PG8_SCHED;
            PG8_LDA(At, 1, 1); PG8_STAGE(PG8_SB(1, 0), b3, voffB); PG8_STAGE(PG8_SB(1, 1), b3 + hstep, voffB); PG8_STAGE(PG8_SA(1, 0), a3, voffA);
            PG8_WAIT_V(8); PG8_WAIT_L(0); PG8_BAR; PG8_MMA(1, 0, At, B0); PG8_MMA(1, 1, At, B1); PG8_BAR; PG8_SCHED;
            } else {
            PG8_LDB(B0, 0, 0); PG8_SCHED; PG8_LDA(At, 0, 0); PG8_STAGE(PG8_SA(1, 1), a1 + hstep, voffA);
            PG8_WAIT_L(8); PG8_BAR; PG8_WAIT_L(0); PG8_MMA(0, 0, At, B0); PG8_BAR; PG8_SCHED;
            PG8_LDB(B1, 0, 1); PG8_STAGE(PG8_SB(0, 0), b2, voffB);
            PG8_BAR; PG8_WAIT_L(0); PG8_MMA(0, 1, At, B1); PG8_BAR;
            PG8_LDA(At, 0, 1); PG8_STAGE(PG8_SA(0, 0), a2, voffA);
            PG8_BAR; PG8_WAIT_L(0); PG8_MMA(1, 0, At, B0); PG8_BAR; PG8_SCHED;
            PG8_STAGE(PG8_SB(0, 1), b2 + hstep, voffB);
            PG8_WAIT_V(6); PG8_BAR; PG8_MMA(1, 1, At, B1); PG8_BAR;
            PG8_LDB(B0, 1, 0); PG8_SCHED; PG8_LDA(At, 1, 0); PG8_STAGE(PG8_SA(0, 1), a2 + hstep, voffA);
            PG8_WAIT_L(8); PG8_BAR; PG8_WAIT_L(0); PG8_MMA(0, 0, At, B0); PG8_BAR; PG8_SCHED;
            PG8_LDB(B1, 1, 1); PG8_STAGE(PG8_SB(1, 0), b3, voffB);
            PG8_BAR; PG8_WAIT_L(0); PG8_MMA(0, 1, At, B1); PG8_BAR;
            PG8_LDA(At, 1, 1); PG8_STAGE(PG8_SA(1, 0), a3, voffA);
            PG8_BAR; PG8_WAIT_L(0); PG8_MMA(1, 0, At, B0); PG8_BAR; PG8_SCHED;
            PG8_STAGE(PG8_SB(1, 1), b3 + hstep, voffB);
            PG8_WAIT_V(6); PG8_BAR; PG8_MMA(1, 1, At, B1); PG8_BAR;
            }
        }
        if constexpr (ALIGN_EPI) { if (wr == 0) PG8_BAR; }
        if constexpr (!Epi::AFTER_DRAIN) { E(acc, cur, wr, wc, fr, fq); S.done(cur); }
        if (!has_next) break;
#pragma unroll
        for (int a = 0; a < 2; ++a)
#pragma unroll
            for (int b = 0; b < 2; ++b)
#pragma unroll
                for (int m = 0; m < 4; ++m)
#pragma unroll
                    for (int n = 0; n < 2; ++n) acc[a][b][m][n] = (f32x4){0.f, 0.f, 0.f, 0.f};
        cur = nxt; cA = nA; cB = nB; ++ui;
        if constexpr (ALIGN_EPI) { if (wr == 1) PG8_BAR; }
    }
    PG8_WAIT_V(0);
    if constexpr (!ALIGN_EPI) { if (wr == 0) PG8_BAR; }
    PG8_BAR;
    if constexpr (Epi::AFTER_DRAIN) { E.fused(acc, cur, wr, wc, fr, fq, lds, wid, lane); S.done(cur); }
#undef PG8_SA
#undef PG8_SB
#undef PG8_STAGE
#undef PG8_LDA
#undef PG8_LDB
#undef PG8_MMA
#undef PG8_WAIT_V
#undef PG8_WAIT_L
#undef PG8_BAR
#undef PG8_SCHED
}

}
#define LAS __attribute__((address_space(3)))
#define XB_TMO      128
#define XB_XCNT(j)  (256  + 64 * (j))
#define XB_XSUB(j)  (1280 + 64 * (j))
#define XB_XGEN(j)  (2304 + 64 * (j))
#define XB_TOP      3328
#define XB_TOPGEN   3392
#define XCD_BAR_WORDS 3456
#define XB_SPIN_CAP (1u << 18)
__device__ __forceinline__ unsigned xb_ld(unsigned* p)              { return __hip_atomic_load(p, __ATOMIC_RELAXED, __HIP_MEMORY_SCOPE_AGENT); }
__device__ __forceinline__ unsigned xb_add(unsigned* p, unsigned v) { return __hip_atomic_fetch_add(p, v, __ATOMIC_RELAXED, __HIP_MEMORY_SCOPE_AGENT); }
__device__ __forceinline__ unsigned xb_xcc_id() { return (unsigned)__builtin_amdgcn_s_getreg((3 << 11) | 20) & 0xFu; }
#define XB_SPIN(cond, bar) do { unsigned _sp = 0; while (cond) { __builtin_amdgcn_s_sleep(1); \
    if ((++_sp & 255u) == 0u) { if (xb_ld(&(bar)[XB_TMO])) break; if (_sp > XB_SPIN_CAP) { atomicAdd(&(bar)[XB_TMO], 1u); break; } } } } while (0)

struct XcdBarrier {
    unsigned* bar; unsigned x;
    volatile LAS unsigned* st;
};

__device__ __forceinline__ XcdBarrier xcd_barrier_post(unsigned* bar, volatile LAS unsigned* st) {
    XcdBarrier b; b.bar = bar; b.x = xb_xcc_id(); b.st = st;
    if (threadIdx.x == 0) (void)xb_add(&bar[XB_XCNT(b.x)], 1u);
    return b;
}
__device__ __forceinline__ void xcd_barrier_complete(unsigned* bar, unsigned x, unsigned& nloc, unsigned& nx) {
    const unsigned G = gridDim.x * gridDim.y * gridDim.z;
    unsigned sum, cnt, mine, sp = 0u;
    for (;;) {
        sum = 0u; cnt = 0u; mine = 0u;
#pragma unroll
        for (unsigned j = 0; j < 16; ++j) { const unsigned c = xb_ld(&bar[XB_XCNT(j)]); sum += c; cnt += (c > 0u) ? 1u : 0u; mine = (j == x) ? c : mine; }
        if (sum == G) break;
        __builtin_amdgcn_s_sleep(1);
        if ((++sp & 255u) == 0u) { if (xb_ld(&bar[XB_TMO])) break; if (sp > XB_SPIN_CAP) { atomicAdd(&bar[XB_TMO], 1u); break; } }
    }
    nloc = mine > 0u ? mine : 1u; nx = cnt > 0u ? cnt : 1u;
}

__device__ __forceinline__ void xcd_barrier(const XcdBarrier& b) {
    asm volatile("s_waitcnt vmcnt(0)" ::: "memory");
    __syncthreads();
    if (threadIdx.x == 0) {
        unsigned* bar = b.bar;
        __builtin_amdgcn_s_waitcnt(0);
        unsigned nloc = b.st[0], nx = b.st[1];
        if (nloc == 0u) { xcd_barrier_complete(bar, b.x, nloc, nx); b.st[0] = nloc; b.st[1] = nx; }
        const unsigned old = xb_add(&bar[XB_XSUB(b.x)], 1u);
        const unsigned gen = old / nloc;
        if (old + 1u == (gen + 1u) * nloc) {
            __builtin_amdgcn_fence(__ATOMIC_RELEASE, "agent");
            asm volatile("s_waitcnt vmcnt(0)" ::: "memory");
            const unsigned og = xb_add(&bar[XB_TOP], 1u);
            const unsigned tg = og / nx;
            if (og + 1u == (tg + 1u) * nx) xb_add(&bar[XB_TOPGEN], 1u);
            else XB_SPIN(xb_ld(&bar[XB_TOPGEN]) == tg, bar);
            __builtin_amdgcn_fence(__ATOMIC_ACQUIRE, "agent");
            xb_add(&bar[XB_XGEN(b.x)], 1u);
            asm volatile("s_waitcnt vmcnt(0)" ::: "memory");
        } else {
            XB_SPIN(xb_ld(&bar[XB_XGEN(b.x)]) == gen, bar);
            __builtin_amdgcn_fence(__ATOMIC_ACQUIRE, "agent");
            asm volatile("s_waitcnt vmcnt(0)" ::: "memory");
        }
    }
    __syncthreads();
}

using pg8::bf16_t; using pg8::bf16x8; using pg8::f32x4; using pg8::u32x4; typedef unsigned u32x2 __attribute__((ext_vector_type(2))); using pg8::Unit; using pg8::Gemm; using pg8::StaticOrder;
#define LAS3 __attribute__((address_space(3)))
DI int ltid() { int t = threadIdx.x; asm volatile("" : "+v"(t)); return t; }
#define LBAR() do { asm volatile("s_waitcnt lgkmcnt(0)" ::: "memory"); __builtin_amdgcn_s_barrier(); asm volatile("" ::: "memory"); } while (0)
#define MFMA16(a, b, c) __builtin_amdgcn_mfma_f32_16x16x32_bf16((a), (b), (c), 0, 0, 0)

struct Params { const float* in[23]; float* out; unsigned char* ws; int ph_lo, ph_hi; };

DI bf16_t* slotp(const Params& P, int s) { return (bf16_t*)(P.ws + WS_ACT + (size_t)s * USLOT); }
DI bf16_t* xrow16(const Params& P, int row) { return row < RL ? (bf16_t*)P.out + (size_t)row * 2048 : (bf16_t*)(P.ws + WS_CTX) + (size_t)(row - RL) * 2048; }

enum { M_H = 0, M_B = 1, M_GATES = 2, M_WA = 3, M_WB = 4, M_UP = 5, M_RES = 6 };
template <int MODE> struct Epi {
    static constexpr bool PERM = true, AFTER_DRAIN = false;
    bf16_t* o0; bf16_t* o1; bf16_t* o2; bf16_t* o3;
    const bf16_t* g0; const bf16_t* g1;
    float* xl; float* xc; const float* gate; float* dryp; const float* sl; const float* sc;
    __device__ __forceinline__ void operator()(const f32x4 (&acc)[2][2][4][2], const Unit& u, int wr, int wc, int fr, int fq) const {
        if constexpr (MODE == M_RES) {
            const int row0 = u.pm * 256 + wr * 64 + fr, colb = u.pn * 256 + wc * 32 + 8 * fq;
            const int mi = (u.pm * 256 < RL) ? ((u.pm * 256) >> 12) : 4; const float* gr = gate + mi * 6144 + colb;
            const f32x4 g00 = *(const f32x4*)gr, g01 = *(const f32x4*)(gr + 4), g10 = *(const f32x4*)(gr + 128), g11 = *(const f32x4*)(gr + 132);
#pragma unroll
            for (int ai = 0; ai < 2; ++ai)
#pragma unroll
                for (int mp = 0; mp < 2; ++mp) {
                    f32x4 xa[2][2][2]; bf16_t* xdp[2];
#pragma unroll
                    for (int mm = 0; mm < 2; ++mm) { const int row = row0 + ai * 128 + (2 * mp + mm) * 16;
                        bf16_t* xd = row < RL ? (bf16_t*)xl + (size_t)row * 2048 : (bf16_t*)xc + (size_t)(row - RL) * 2048; xdp[mm] = xd;
                        if (sl) { const float* xs = (row < RL ? sl + (size_t)row * 1024 : sc + (size_t)(row - RL) * 1024) + colb;
#pragma unroll
                            for (int bj = 0; bj < 2; ++bj) { xa[mm][bj][0] = *(const f32x4*)(xs + bj * 128); xa[mm][bj][1] = *(const f32x4*)(xs + bj * 128 + 4); } }
                        else {
#pragma unroll
                            for (int bj = 0; bj < 2; ++bj) { const u32x4 xw = *(const u32x4*)(xd + colb + bj * 128); xa[mm][bj][0] = (f32x4){bflo(xw.x), bfhi(xw.x), bflo(xw.y), bfhi(xw.y)}; xa[mm][bj][1] = (f32x4){bflo(xw.z), bfhi(xw.z), bflo(xw.w), bfhi(xw.w)}; } } }
#pragma unroll
                    for (int mm = 0; mm < 2; ++mm)
#pragma unroll
                        for (int bj = 0; bj < 2; ++bj) { const int m = 2 * mp + mm;
                            const f32x4 x0 = xa[mm][bj][0] + (bj ? g10 : g00) * acc[ai][bj][m][0], x1 = xa[mm][bj][1] + (bj ? g11 : g01) * acc[ai][bj][m][1];
                            u32x4 w; w.x = pk2(x0[0], x0[1]); w.y = pk2(x0[2], x0[3]); w.z = pk2(x1[0], x1[1]); w.w = pk2(x1[2], x1[3]); *(u32x4*)(xdp[mm] + colb + bj * 128) = w; }
                    asm volatile("" ::: "memory");
                }
        } else {
            const int row0 = u.pm * 256 + wr * 64 + fr;
            int part = 0, colt = u.pn * 256, ld = 1024; bf16_t* ob = o0;
            if constexpr (MODE == M_H || MODE == M_B || MODE == M_GATES) { part = u.pn >> 2; colt = (u.pn & 3) * 256; ob = part == 0 ? o0 : (part == 1 ? o1 : (part == 2 ? o2 : o3)); }
            if constexpr (MODE == M_UP) { ld = DFF; if (u.pn >= 11) { ob = o1; colt = (u.pn - 11) * 256; } }
#pragma unroll
            for (int ai = 0; ai < 2; ++ai)
#pragma unroll
                for (int m = 0; m < 4; ++m) {
                    const int row = row0 + ai * 128 + m * 16; float st1 = 0.f, st2 = 0.f;
#pragma unroll
                    for (int bj = 0; bj < 2; ++bj) {
                        const int col = colt + bj * 128 + wc * 32 + 8 * fq; const size_t off = (size_t)row * ld + col;
                        float v[8]; { const f32x4 a = acc[ai][bj][m][0], b = acc[ai][bj][m][1]; v[0] = a[0]; v[1] = a[1]; v[2] = a[2]; v[3] = a[3]; v[4] = b[0]; v[5] = b[1]; v[6] = b[2]; v[7] = b[3]; }
                        u32x4 w;
                        if constexpr (MODE == M_H) {
                            if (part == 1 || part == 2) { const float* lbp = gate + (part - 1) * 1024 + col; const f32x4 l0 = *(const f32x4*)lbp, l1 = *(const f32x4*)(lbp + 4); const float lbv[8] = {l0[0], l0[1], l0[2], l0[3], l1[0], l1[1], l1[2], l1[3]};
#pragma unroll
                                for (int j = 0; j < 8; ++j) v[j] = fmaxf(__builtin_amdgcn_logf(lbv[j] + (1.0f - lbv[j]) * sigm(v[j])), -43.0f);
                                w.x = pkh2(v[0], v[1]); w.y = pkh2(v[2], v[3]); w.z = pkh2(v[4], v[5]); w.w = pkh2(v[6], v[7]); }
                            else { if (part == 0) {
#pragma unroll
                                    for (int j = 0; j < 8; ++j) v[j] = silu_f(v[j]); }
                                w.x = pk2(v[0], v[1]); w.y = pk2(v[2], v[3]); w.z = pk2(v[4], v[5]); w.w = pk2(v[6], v[7]); }
                        } else {
                            if constexpr (MODE == M_B) {
                                if (part >= 3) { unsigned q[8];
#pragma unroll
                                    for (int j = 0; j < 8; ++j) q[j] = (unsigned)(sigm(v[j]) * 255.0f + 0.5f);
                                    u32x2 wb; wb.x = q[0] | (q[1] << 8) | (q[2] << 16) | (q[3] << 24); wb.y = q[4] | (q[5] << 8) | (q[6] << 16) | (q[7] << 24);
                                    *(u32x2*)((unsigned char*)o3 + (size_t)row * 2048 + (part - 3) * 1024 + col) = wb; continue; }
                                if (part == 2) {
#pragma unroll
                                    for (int j = 0; j < 8; ++j) v[j] = silu_f(v[j]); }
                                else {
#pragma unroll
                                    for (int j = 0; j < 8; ++j) v[j] = gelu_t(v[j]);
                                    if (part == 1) { float s1 = 0.f, s2 = 0.f;
#pragma unroll
                                        for (int j = 0; j < 8; ++j) { s1 += v[j]; s2 += v[j] * v[j]; }
                                        st1 += s1; st2 += s2; } } }
                            if constexpr (MODE == M_GATES) {
#pragma unroll
                                for (int j = 0; j < 8; ++j) v[j] = sigm(v[j]); }
                            if constexpr (MODE == M_WA || MODE == M_WB) {
                                const u32x2 gw = *(const u32x2*)((const unsigned char*)g0 + (size_t)row * 2048 + col);
                                constexpr float I255 = 1.0f / 255.0f;
                                v[0] *= (float)(gw.x & 255u) * I255; v[1] *= (float)((gw.x >> 8) & 255u) * I255; v[2] *= (float)((gw.x >> 16) & 255u) * I255; v[3] *= (float)(gw.x >> 24) * I255;
                                v[4] *= (float)(gw.y & 255u) * I255; v[5] *= (float)((gw.y >> 8) & 255u) * I255; v[6] *= (float)((gw.y >> 16) & 255u) * I255; v[7] *= (float)(gw.y >> 24) * I255; }
                            if constexpr (MODE == M_WB) {
                                const u32x4 tw = *(const u32x4*)(g1 + off);
                                v[0] += bflo(tw.x); v[1] += bfhi(tw.x); v[2] += bflo(tw.y); v[3] += bfhi(tw.y); v[4] += bflo(tw.z); v[5] += bfhi(tw.z); v[6] += bflo(tw.w); v[7] += bfhi(tw.w); }
                            w.x = pk2(v[0], v[1]); w.y = pk2(v[2], v[3]); w.z = pk2(v[4], v[5]); w.w = pk2(v[6], v[7]);
                        }
                        *(u32x4*)(ob + off) = w;
                    }
                    if constexpr (MODE == M_B) { if (part == 1) { st1 += __shfl_xor(st1, 16); st1 += __shfl_xor(st1, 32); st2 += __shfl_xor(st2, 16); st2 += __shfl_xor(st2, 32);
                            if (fq == 0) { float* sp = (float*)gate + ((size_t)row * 16 + (u.pn & 3) * 4 + wc) * 2; *(float2*)sp = make_float2(st1, st2); } } }
                    if (!(MODE == M_WA || MODE == M_WB) || (m & 1)) asm volatile("" ::: "memory");
                }
        }
    }
};

template <int MODE> DI void run_gemm(unsigned char* lds, const bf16_t* A, const bf16_t* Bt, int M, int N, int K, const Epi<MODE>& E) {
    Gemm g{A, Bt, M, N, K}; StaticOrder S; S.init(M, N, (int)gridDim.x, (int)blockIdx.x);
    pg8::gemm_phase<Epi<MODE>, StaticOrder, true, true>((LAS3 unsigned char*)lds, g, S, E);
}

DI void ctx_res_gemm(const Params& P, unsigned char* lds, const bf16_t* A, int lda, const bf16_t* Bt, int K, const float* gate, const float* xsrc_f32) {
    const int tid = ltid(), lane = tid & 63, wid = tid >> 6, fr = lane & 15, fq = lane >> 4;
    unsigned short* LA = (unsigned short*)lds; unsigned short* LB = LA + 64 * 264;
    for (int tile = blockIdx.x; tile < 256; tile += gridDim.x) {
        const int tm = tile >> 4, tn = tile & 15;
        const bf16_t* ag = A + (size_t)(tm * 64) * lda; const bf16_t* bg = Bt + (size_t)(tn * 64) * K;
        uint4 ra0, ra1, ra2, ra3, rb0, rb1, rb2, rb3;
        const int pr_ = tid >> 5, pc_ = (tid & 31) * 8;
#define CTX_FETCH(k0) do { const bf16_t* a_ = ag + (size_t)pr_ * lda + (k0) + pc_; const bf16_t* b_ = bg + (size_t)pr_ * K + (k0) + pc_; \
            ra0 = *(const uint4*)a_; ra1 = *(const uint4*)(a_ + (size_t)16 * lda); ra2 = *(const uint4*)(a_ + (size_t)32 * lda); ra3 = *(const uint4*)(a_ + (size_t)48 * lda); \
            rb0 = *(const uint4*)b_; rb1 = *(const uint4*)(b_ + (size_t)16 * K); rb2 = *(const uint4*)(b_ + (size_t)32 * K); rb3 = *(const uint4*)(b_ + (size_t)48 * K); } while (0)
        CTX_FETCH(0);
        f32x4 acc0 = (f32x4){0.f, 0.f, 0.f, 0.f}, acc1 = acc0;
        for (int k = 0; k < K; k += 256) {
            __syncthreads();
            { unsigned short* la_ = LA + pr_ * 264 + pc_; unsigned short* lb_ = LB + pr_ * 264 + pc_;
                *(uint4*)la_ = ra0; *(uint4*)(la_ + 16 * 264) = ra1; *(uint4*)(la_ + 32 * 264) = ra2; *(uint4*)(la_ + 48 * 264) = ra3;
                *(uint4*)lb_ = rb0; *(uint4*)(lb_ + 16 * 264) = rb1; *(uint4*)(lb_ + 32 * 264) = rb2; *(uint4*)(lb_ + 48 * 264) = rb3; }
            __syncthreads();
            if (k + 256 < K) CTX_FETCH(k + 256);
            bf16x8 a[8], b0[8], b1[8];
#pragma unroll
            for (int j = 0; j < 8; ++j) { a[j] = *(const bf16x8*)(LA + (16 * (wid & 3) + fr) * 264 + 32 * j + 8 * fq); b0[j] = *(const bf16x8*)(LB + (32 * (wid >> 2) + fr) * 264 + 32 * j + 8 * fq); b1[j] = *(const bf16x8*)(LB + (32 * (wid >> 2) + 16 + fr) * 264 + 32 * j + 8 * fq); }
#pragma unroll
            for (int j = 0; j < 8; ++j) { acc0 = MFMA16(b0[j], a[j], acc0); acc1 = MFMA16(b1[j], a[j], acc1); }
        }
#undef CTX_FETCH
        const int row = tm * 64 + 16 * (wid & 3) + fr, c0 = tn * 64 + 32 * (wid >> 2); bf16_t* xd = (bf16_t*)(P.ws + WS_CTX) + (size_t)row * 2048;
#pragma unroll
        for (int e = 0; e < 2; ++e) { const int col = c0 + 16 * e + 4 * fq; const f32x4 acc = e ? acc1 : acc0; const f32x4 gv = *(const f32x4*)(gate + col); f32x4 xv;
            if (xsrc_f32) xv = *(const f32x4*)(xsrc_f32 + (size_t)row * 1024 + col);
            else { const uint2 xw = *(const uint2*)(xd + col); xv = (f32x4){bflo(xw.x), bfhi(xw.x), bflo(xw.y), bfhi(xw.y)}; }
            xv = xv + gv * acc; uint2 w; w.x = pk2(xv[0], xv[1]); w.y = pk2(xv[2], xv[3]); *(uint2*)(xd + col) = w; }
    }
}

DI void ctx_ab_gemm(const Params& P, unsigned char* lds) {
    const int tid = ltid(), lane = tid & 63, wid = tid >> 6, fr = lane & 15, fq = lane >> 4;
    unsigned short* LA = (unsigned short*)lds; unsigned short* LB = LA + 64 * 264;
    const bf16_t* ya = slotp(P, 3) + (size_t)RL * 1024; const bf16_t* yb = slotp(P, 1) + (size_t)RL * 1024;
    const bf16_t* Wa = (const bf16_t*)(P.ws + WS_WA); const bf16_t* Wb = (const bf16_t*)(P.ws + WS_WB);
    const int pr_ = tid >> 5, pc_ = (tid & 31) * 8;
    for (int tile = blockIdx.x; tile < 256; tile += gridDim.x) {
        const int tm = tile >> 4, tn = tile & 15;
        uint4 ra0, ra1, ra2, ra3, rb0, rb1, rb2, rb3;
#define AB_FETCH(si) do { const bf16_t* a_ = (((si) >> 2) ? yb : ya) + (size_t)(tm * 64 + pr_) * 1024 + ((si) & 3) * 256 + pc_; const bf16_t* b_ = (((si) >> 2) ? Wb : Wa) + (size_t)(tn * 64 + pr_) * 1024 + ((si) & 3) * 256 + pc_; \
            ra0 = *(const uint4*)a_; ra1 = *(const uint4*)(a_ + 16 * 1024); ra2 = *(const uint4*)(a_ + 32 * 1024); ra3 = *(const uint4*)(a_ + 48 * 1024); \
            rb0 = *(const uint4*)b_; rb1 = *(const uint4*)(b_ + 16 * 1024); rb2 = *(const uint4*)(b_ + 32 * 1024); rb3 = *(const uint4*)(b_ + 48 * 1024); } while (0)
        AB_FETCH(0);
        f32x4 acc[2][2];
        acc[0][0] = (f32x4){0.f, 0.f, 0.f, 0.f}; acc[0][1] = acc[0][0]; acc[1][0] = acc[0][0]; acc[1][1] = acc[0][0];
#pragma unroll
        for (int si = 0; si < 8; ++si) {
            __syncthreads();
            { unsigned short* la_ = LA + pr_ * 264 + pc_; unsigned short* lb_ = LB + pr_ * 264 + pc_;
                *(uint4*)la_ = ra0; *(uint4*)(la_ + 16 * 264) = ra1; *(uint4*)(la_ + 32 * 264) = ra2; *(uint4*)(la_ + 48 * 264) = ra3;
                *(uint4*)lb_ = rb0; *(uint4*)(lb_ + 16 * 264) = rb1; *(uint4*)(lb_ + 32 * 264) = rb2; *(uint4*)(lb_ + 48 * 264) = rb3; }
            __syncthreads();
            if (si + 1 < 8) AB_FETCH(si + 1);
            bf16x8 a[8], b0[8], b1[8];
#pragma unroll
            for (int j = 0; j < 8; ++j) { a[j] = *(const bf16x8*)(LA + (16 * (wid & 3) + fr) * 264 + 32 * j + 8 * fq); b0[j] = *(const bf16x8*)(LB + (32 * (wid >> 2) + fr) * 264 + 32 * j + 8 * fq); b1[j] = *(const bf16x8*)(LB + (32 * (wid >> 2) + 16 + fr) * 264 + 32 * j + 8 * fq); }
#pragma unroll
            for (int j = 0; j < 8; ++j) { acc[si >> 2][0] = MFMA16(b0[j], a[j], acc[si >> 2][0]); acc[si >> 2][1] = MFMA16(b1[j], a[j], acc[si >> 2][1]); }
        }
#undef AB_FETCH
        const int grow = RL + tm * 64 + 16 * (wid & 3) + fr, c0 = tn * 64 + 32 * (wid >> 2);
        const unsigned char* gp = (const unsigned char*)slotp(P, 6) + (size_t)grow * 2048; bf16_t* md = slotp(P, 2) + (size_t)grow * 1024; constexpr float I255 = 1.0f / 255.0f;
#pragma unroll
        for (int e = 0; e < 2; ++e) { const int col = c0 + 16 * e + 4 * fq; const unsigned ga = *(const unsigned*)(gp + col), gb = *(const unsigned*)(gp + 1024 + col);
            const f32x4 A = acc[0][e], B = acc[1][e]; float m[4];
#pragma unroll
            for (int i = 0; i < 4; ++i) m[i] = (float)((ga >> (8 * i)) & 255u) * I255 * A[i] + (float)((gb >> (8 * i)) & 255u) * I255 * B[i];
            uint2 w; w.x = pk2(m[0], m[1]); w.y = pk2(m[2], m[3]); *(uint2*)(md + col) = w; }
    }
}

struct ConvItem { const float* src; bf16_t* dst; int K, N, tile; };
constexpr int CV_IN = 16 * 144, CV_SQ = 256, CV_UP = 16 * 88, CV_DN = 44 * 16, CV_WS = 32;
constexpr int CV_E0 = CV_IN, CV_E1 = CV_E0 + CV_SQ, CV_E2 = CV_E1 + CV_SQ, CV_E3 = CV_E2 + CV_SQ, CV_E4 = CV_E3 + CV_UP, CV_E5 = CV_E4 + CV_DN, CV_E6 = CV_E5 + CV_WS;
DI bool conv_item(const Params& P, int l, int it, int sel, ConvItem& c) {
    if (it >= CV_E5) return false;
    const bool is_dn = (it >= CV_E4), is_in = it < CV_E0; if ((sel == 1 && is_dn) || (sel == 2 && !is_dn) || (sel == 3 && !is_in) || (sel == 4 && is_in)) return false;
    if (it < CV_E0) { c.src = P.in[7] + (size_t)l * 1024 * DIN; c.dst = (bf16_t*)(P.ws + WS_WIN); c.K = 1024; c.N = DIN; c.tile = it; }
    else if (it < CV_E1) { c.src = P.in[14] + (size_t)l * 1024 * 1024; c.dst = (bf16_t*)(P.ws + WS_WA); c.K = 1024; c.N = 1024; c.tile = it - CV_E0; }
    else if (it < CV_E2) { c.src = P.in[15] + (size_t)l * 1024 * 1024; c.dst = (bf16_t*)(P.ws + WS_WB); c.K = 1024; c.N = 1024; c.tile = it - CV_E1; }
    else if (it < CV_E3) { c.src = P.in[16] + (size_t)l * 1024 * 1024; c.dst = (bf16_t*)(P.ws + WS_WO); c.K = 1024; c.N = 1024; c.tile = it - CV_E2; }
    else if (it < CV_E4) { c.src = P.in[18] + (size_t)l * 1024 * 2 * DFF; c.dst = (bf16_t*)(P.ws + WS_WUP); c.K = 1024; c.N = 2 * DFF; c.tile = it - CV_E3; }
    else { c.src = P.in[21] + (size_t)l * DFF * 1024; c.dst = (bf16_t*)(P.ws + WS_WDN); c.K = DFF; c.N = 1024; c.tile = it - CV_E4; }
    return true;
}
DI void convert_weights(const Params& P, int l, unsigned char* lds, int sel = 0, int first_wg = 0) {
    unsigned short* T = (unsigned short*)lds;
    if ((int)blockIdx.x < first_wg) return;
    const int tid = ltid(), step = (int)gridDim.x - first_wg, kr = tid >> 4, nc = (tid & 15) * 4;
    int it = (int)blockIdx.x - first_wg; ConvItem cur{}, nxt{}; bool hc = false;
    while (it < CV_E5 && !(hc = conv_item(P, l, it, sel, cur))) it += step;
    float4 v0 = make_float4(0.f, 0.f, 0.f, 0.f), v1 = v0;
#define CV_FETCH(ci) do { const int ntn_ = (ci).N >> 6, tk_ = (ci).tile / ntn_, tn_ = (ci).tile - tk_ * ntn_; const float* s_ = (ci).src + (size_t)(tk_ * 64 + kr) * (ci).N + tn_ * 64 + nc; v0 = *(const float4*)s_; v1 = *(const float4*)(s_ + (size_t)32 * (ci).N); } while (0)
    if (hc) CV_FETCH(cur);
    while (hc) {
        int itn = it + step; bool hn = false;
        while (itn < CV_E5 && !(hn = conv_item(P, l, itn, sel, nxt))) itn += step;
        T[(nc + 0) * 72 + kr] = f2bf(v0.x); T[(nc + 1) * 72 + kr] = f2bf(v0.y); T[(nc + 2) * 72 + kr] = f2bf(v0.z); T[(nc + 3) * 72 + kr] = f2bf(v0.w);
        T[(nc + 0) * 72 + kr + 32] = f2bf(v1.x); T[(nc + 1) * 72 + kr + 32] = f2bf(v1.y); T[(nc + 2) * 72 + kr + 32] = f2bf(v1.z); T[(nc + 3) * 72 + kr + 32] = f2bf(v1.w);
        __syncthreads();
        if (hn) CV_FETCH(nxt);
        { const int ntn = cur.N >> 6, tk = cur.tile / ntn, tn = cur.tile - tk * ntn, n = tid >> 3, kc = (tid & 7) * 8; const uint4 w = *(const uint4*)(T + n * 72 + kc); *(uint4*)(cur.dst + (size_t)(tn * 64 + n) * cur.K + tk * 64 + kc) = w; }
        __syncthreads();
        cur = nxt; it = itn; hc = hn;
    }
#undef CV_FETCH
    if (sel == 0 || sel == 4 || sel == 1) for (int t = (int)blockIdx.x - first_wg; t < CV_WS; t += step) { const float* sp = P.in[10] + (size_t)l * 8 * 128 * 128 + t * 4096; bf16_t* d = (bf16_t*)(P.ws + WS_WS) + t * 4096;
        for (int i = tid; i < 4096; i += 512) d[i] = f2bf(sp[i]); }
}

DI void phase_prologue(const Params& P, unsigned char* lds) {
    const int tid = ltid(), bid = blockIdx.x, G = gridDim.x;
    float* sl = (float*)lds; float* red = sl + 5 * 1024; float* modt = (float*)(P.ws + WS_MOD);
    bool have = false;
    for (int it = bid; it < 96; it += G) {
        if (!have) { for (int i = tid; i < 5 * 1024; i += 512) { const int m = i >> 10, k = i & 1023; const float c = m < 4 ? P.in[1][m * 1024 + k] : P.in[3][k]; sl[i] = c / (1.0f + expf(-c)); } __syncthreads(); have = true; }
        const int l = it / 48, cb = it - l * 48, col = cb * 128 + (tid & 127), kq = tid >> 7;
        const float* W = P.in[4] + (size_t)l * 1024 * 6144 + col;
        float a0 = 0.f, a1 = 0.f, a2 = 0.f, a3 = 0.f, a4 = 0.f;
#pragma unroll 16
        for (int k = kq * 256; k < kq * 256 + 256; ++k) { const float w = W[(size_t)k * 6144]; a0 += sl[k] * w; a1 += sl[1024 + k] * w; a2 += sl[2048 + k] * w; a3 += sl[3072 + k] * w; a4 += sl[4096 + k] * w; }
        float* rr = red + (kq * 5) * 128 + (tid & 127); rr[0] = a0; rr[128] = a1; rr[256] = a2; rr[384] = a3; rr[512] = a4;
        __syncthreads();
        if (tid < 128) { const float bias = P.in[5][l * 6144 + col];
#pragma unroll
            for (int m = 0; m < 5; ++m) modt[(l * 5 + m) * 6144 + col] = red[(0 * 5 + m) * 128 + tid] + red[(1 * 5 + m) * 128 + tid] + red[(2 * 5 + m) * 128 + tid] + red[(3 * 5 + m) * 128 + tid] + bias; }
        __syncthreads();
    }
    if (bid == G - 1) { float* lbt = (float*)(P.ws + WS_LB); for (int i = tid; i < 2048; i += 512) { const float h0 = P.in[12][i], h1 = P.in[12][2048 + i]; lbt[i] = 0.f; lbt[2048 + i] = 1.0f / (1.0f + expf(h0 - h1)); } }
    __syncthreads();
    convert_weights(P, 0, lds, 3, 96);
}

DI void norm_phase(const Params& P, int l, int which, bf16_t* dst, int nrows) {
    const bool from_in = (l == 0 && which == 0);
    const int tid_ = ltid(); const int lane = tid_ & 63, wid = tid_ >> 6;
    const float* nw = (which ? P.in[17] : P.in[6]) + l * 1024; const float* modt = (const float*)(P.ws + WS_MOD) + (size_t)l * 5 * 6144 + (which ? 3 : 0) * 1024;
    const int nw_tot = gridDim.x * 8;
    for (int rowb = blockIdx.x * 8 + wid; rowb < nrows; rowb += 2 * nw_tot) {
        float4 v[2][4]; int rows[2] = {rowb, rowb + nw_tot};
#pragma unroll
        for (int r = 0; r < 2; ++r) { const int row = rows[r] < nrows ? rows[r] : rowb;
            if (from_in) { const float4* xr = (const float4*)(row < RL ? P.in[0] + (size_t)row * 1024 : P.in[2] + (size_t)(row - RL) * 1024);
#pragma unroll
                for (int q = 0; q < 4; ++q) v[r][q] = xr[q * 64 + lane]; }
            else { const uint2* xr = (const uint2*)xrow16(P, row);
#pragma unroll
                for (int q = 0; q < 4; ++q) { const uint2 w = xr[q * 64 + lane]; v[r][q] = make_float4(bflo(w.x), bfhi(w.x), bflo(w.y), bfhi(w.y)); } } }
#pragma unroll
        for (int r = 0; r < 2; ++r) { const int row = rows[r]; if (row >= nrows) continue; float ss = 0.f;
#pragma unroll
            for (int q = 0; q < 4; ++q) ss += v[r][q].x * v[r][q].x + v[r][q].y * v[r][q].y + v[r][q].z * v[r][q].z + v[r][q].w * v[r][q].w;
            ss = wave_sum(ss); const float rstd = __builtin_amdgcn_rsqf(ss * (1.0f / 1024.0f) + 1e-6f);
            const int mi = row < RL ? (row >> 12) : 4; const float* sh = modt + mi * 6144; const float* sc = sh + 1024;
#pragma unroll
            for (int q = 0; q < 4; ++q) { const int col = 4 * (q * 64 + lane); const float4 w = *(const float4*)(nw + col), s = *(const float4*)(sc + col), h = *(const float4*)(sh + col);
                uint2 o; o.x = pk2(v[r][q].x * rstd * w.x * (1.f + s.x) + h.x, v[r][q].y * rstd * w.y * (1.f + s.y) + h.y); o.y = pk2(v[r][q].z * rstd * w.z * (1.f + s.z) + h.z, v[r][q].w * rstd * w.w * (1.f + s.w) + h.w);
                *(uint2*)(dst + (size_t)row * 1024 + col) = o; } }
    }
}

DI int scan_row0(int c, int b, int dir) { if (c < 4) { const int m = dir ? 3 - c : c; return RL + b * 256 + 64 * m; } const int n = c - 4, nn = dir ? 63 - n : n; return b * 4096 + 64 * nn; }
DI void scanprep_phase(const Params& P, unsigned char* lds, int l) {
    const int tid = ltid(), lane = tid & 63, to = tid >> 6, k0 = 2 * lane;
    float* tot = (float*)lds;
    const unsigned short* qh = slotp(P, 1); float* vec = (float*)(P.ws + WS_VEC);
    unsigned gr[8], qr[8];
#define PREP_LOAD(it) do { const int ch_ = (it) >> 4, hd_ = ((it) >> 1) & 7, dr_ = (it) & 1; unsigned vb_ = (unsigned)((ch_ * 64 + (dr_ ? 63 - 8 * to : 8 * to)) * 1024 + hd_ * 128 + k0); asm volatile("" : "+v"(vb_)); \
        const unsigned short* gb_ = slotp(P, dr_ ? 3 : 2); const int st_ = dr_ ? -1024 : 1024; \
        _Pragma("unroll") for (int j = 0; j < 8; ++j) { const unsigned o_ = vb_ + (unsigned)(j * st_); gr[j] = *(const unsigned*)(gb_ + o_); qr[j] = *(const unsigned*)(qh + o_); } } while (0)
    int item = blockIdx.x;
    if (item < 272 * 16) PREP_LOAD(item);
    for (; item < 272 * 16; item += gridDim.x) {
        const int chunk = item >> 4, hd = (item >> 1) & 7, dir = item & 1;
        float g0[8], g1[8]; float run0 = 0.f, run1 = 0.f; unsigned qc[8];
#pragma unroll
        for (int j = 0; j < 8; ++j) { g0[j] = h2f((unsigned short)(gr[j] & 0xffffu)); g1[j] = h2f((unsigned short)(gr[j] >> 16)); run0 += g0[j]; run1 += g1[j]; qc[j] = qr[j]; }
        if (item + (int)gridDim.x < 272 * 16) PREP_LOAD(item + (int)gridDim.x);
        *(float2*)(tot + to * 128 + k0) = make_float2(run0, run1);
        LBAR();
        float off0 = 0.f, off1 = 0.f, ref0 = 0.f, ref1 = 0.f, a0 = 0.f, a1 = 0.f;
#pragma unroll
        for (int o = 0; o < 8; ++o) { const float2 t = *(const float2*)(tot + o * 128 + k0); if (o == to) { off0 = a0; off1 = a1; } a0 += t.x; a1 += t.y; if (o == 3) { ref0 = a0; ref1 = a1; } }
        float bb0 = off0, bb1 = off1; unsigned qo[8], ko[8];
#pragma unroll
        for (int j = 0; j < 8; ++j) { bb0 += g0[j]; bb1 += g1[j];
            const float kk0 = 1.0f - __builtin_amdgcn_exp2f(g0[j]), kk1 = 1.0f - __builtin_amdgcn_exp2f(g1[j]);
            const float E0 = __builtin_amdgcn_exp2f(bb0 - ref0), E1 = __builtin_amdgcn_exp2f(bb1 - ref1), R0 = __builtin_amdgcn_rcpf(E0), R1 = __builtin_amdgcn_rcpf(E1);
            qo[j] = pk2(bflo(qc[j]) * E0, bfhi(qc[j]) * E1); ko[j] = pk2(kk0 * R0, kk1 * R1); }
        { unsigned vb_ = (unsigned)((chunk * 64 + (dir ? 63 - 8 * to : 8 * to)) * 1024 + hd * 128 + k0); asm volatile("" : "+v"(vb_));
            unsigned short* qb_ = slotp(P, dir ? 3 : 2); unsigned short* kb_ = slotp(P, 5 + dir); const int st_ = dir ? -1024 : 1024;
#pragma unroll
            for (int j = 0; j < 8; ++j) { const unsigned o_ = vb_ + (unsigned)(j * st_); *(unsigned*)(qb_ + o_) = qo[j]; *(unsigned*)(kb_ + o_) = ko[j]; } }
        if (to == 0) { float* vc = vec + (size_t)((chunk * 8 + hd) * 2 + dir) * 256; *(float2*)(vc + k0) = make_float2(__builtin_amdgcn_exp2f(ref0), __builtin_amdgcn_exp2f(ref1)); *(float2*)(vc + 128 + k0) = make_float2(__builtin_amdgcn_exp2f(a0 - ref0), __builtin_amdgcn_exp2f(a1 - ref1)); }
        LBAR();
    }
#undef PREP_LOAD
}
DI void scan_phase(const Params& P, unsigned char* lds, int l) {
    const int tid = ltid(), lane = tid & 63, wid = tid >> 6, fr = lane & 15, fq = lane >> 4;
    const int bid = blockIdx.x; if (bid >= 256) return;
    const int vq = bid >> 6, b = (bid >> 4) & 3, hd = (bid >> 1) & 7, dir = bid & 1;
    unsigned short* Qt = (unsigned short*)lds; unsigned short* Kt = Qt + 64 * 136; unsigned short* KtT = Kt + 64 * 136;
    unsigned short* VT = KtT + 128 * 72; unsigned short* Pm = VT + 32 * 72; unsigned short* ST = Pm + 64 * 72;
    const unsigned short* qi = slotp(P, dir ? 3 : 2); const unsigned short* kb = slotp(P, 5 + dir); const unsigned short* iv = slotp(P, 4); const float* vec = (const float*)(P.ws + WS_VEC);
    const unsigned opitch = dir ? 2048u : 1024u;
    const int to = wid, k0 = 2 * lane, cidx = hd * 128 + k0; const bool vmine = (lane >> 4) == vq;
    for (int i = tid; i < 32 * 136 / 2; i += 512) ((unsigned*)ST)[i] = 0u;
    f32x4 S[2];
    S[0] = (f32x4){0.f, 0.f, 0.f, 0.f}; S[1] = (f32x4){0.f, 0.f, 0.f, 0.f};
    unsigned qa_[8], ka_[8], va_[8], qb_r[8], kb_r[8], vb_r[8]; f32x4 era, ela, erb, elb;
    const unsigned vbase = (unsigned)((dir ? 63 - 8 * to : 8 * to) * 1024 + cidx); const int vstep = dir ? -1024 : 1024;
#define SCAN_LOAD(rb, Q_, K_, V_, E_, L_) do { unsigned vb_ = vbase; asm volatile("" : "+v"(vb_)); const unsigned short* qb_ = qi + (size_t)(rb) * 1024; const unsigned short* kb_ = kb + (size_t)(rb) * 1024; const unsigned short* ib_ = iv + (size_t)(rb) * 1024; \
        _Pragma("unroll") for (int j = 0; j < 8; ++j) { const unsigned o_ = vb_ + (unsigned)(j * vstep); Q_[j] = *(const unsigned*)(qb_ + o_); K_[j] = *(const unsigned*)(kb_ + o_); if (vmine) V_[j] = *(const unsigned*)(ib_ + o_); } \
        const float* vc_ = vec + (size_t)(((rb) >> 6) * 8 + hd) * 2 * 256 + dir * 256 + 16 * wid + 4 * fq; E_ = *(const f32x4*)vc_; L_ = *(const f32x4*)(vc_ + 128); } while (0)
#define SCAN_ITER(CC, QR, KR, VR, ER, EL, ERN) do { \
        const int row0 = scan_row0(CC, b, dir); const f32x4 erc = ER, elc = EL; \
        _Pragma("unroll") for (int j = 0; j < 8; ++j) { const int tau = 8 * to + j; *(unsigned*)(Qt + tau * 136 + k0) = QR[j]; *(unsigned*)(Kt + tau * 136 + k0) = KR[j]; } \
        { uint4 w; w.x = (KR[0] & 0xffffu) | (KR[1] << 16); w.y = (KR[2] & 0xffffu) | (KR[3] << 16); w.z = (KR[4] & 0xffffu) | (KR[5] << 16); w.w = (KR[6] & 0xffffu) | (KR[7] << 16); *(uint4*)(KtT + k0 * 72 + 8 * to) = w; \
            w.x = (KR[0] >> 16) | (KR[1] & 0xffff0000u); w.y = (KR[2] >> 16) | (KR[3] & 0xffff0000u); w.z = (KR[4] >> 16) | (KR[5] & 0xffff0000u); w.w = (KR[6] >> 16) | (KR[7] & 0xffff0000u); *(uint4*)(KtT + (k0 + 1) * 72 + 8 * to) = w; } \
        if (vmine) { const int vl = k0 & 31; uint4 w; w.x = (VR[0] & 0xffffu) | (VR[1] << 16); w.y = (VR[2] & 0xffffu) | (VR[3] << 16); w.z = (VR[4] & 0xffffu) | (VR[5] << 16); w.w = (VR[6] & 0xffffu) | (VR[7] << 16); *(uint4*)(VT + vl * 72 + 8 * to) = w; \
            w.x = (VR[0] >> 16) | (VR[1] & 0xffff0000u); w.y = (VR[2] >> 16) | (VR[3] & 0xffff0000u); w.z = (VR[4] >> 16) | (VR[5] & 0xffff0000u); w.w = (VR[6] >> 16) | (VR[7] & 0xffff0000u); *(uint4*)(VT + (vl + 1) * 72 + 8 * to) = w; } \
        if ((CC) + 2 < 68) { SCAN_LOAD(scan_row0((CC) + 2, b, dir), QR, KR, VR, ER, EL); } \
        LBAR(); \
        const bool live_ = !(l == 1 && (CC) < 4);                                    \
        if (live_) { const int ti = wid >> 1; \
            _Pragma("unroll") for (int e = 0; e < 2; ++e) { const int si = 2 * (wid & 1) + e; f32x4 acc = (f32x4){0.f, 0.f, 0.f, 0.f}; \
                if (si <= ti) { \
                    _Pragma("unroll") for (int ks = 0; ks < 4; ++ks) { const bf16x8 a = *(const bf16x8*)(Qt + (16 * ti + fr) * 136 + 32 * ks + 8 * fq); const bf16x8 bq = *(const bf16x8*)(Kt + (16 * si + fr) * 136 + 32 * ks + 8 * fq); acc = MFMA16(bq, a, acc); } } \
                const int t = 16 * ti + fr, s0 = 16 * si + 4 * fq; uint2 w; w.x = pk2(s0 <= t ? acc[0] : 0.f, s0 + 1 <= t ? acc[1] : 0.f); w.y = pk2(s0 + 2 <= t ? acc[2] : 0.f, s0 + 3 <= t ? acc[3] : 0.f); \
                *(uint2*)(Pm + t * 72 + s0) = w; } } \
        LBAR(); \
        if (live_) { const int tt = wid & 3, vtl = wid >> 2; f32x4 acc = (f32x4){0.f, 0.f, 0.f, 0.f}; \
            unsigned ob_ = (unsigned)(dir ? 63 - (16 * tt + fr) : 16 * tt + fr) * opitch + (unsigned)(hd * 128 + 32 * vq + 16 * vtl + 4 * fq); asm volatile("" : "+v"(ob_)); \
            unsigned short* oo = dir ? xrow16(P, row0) + 1024 : slotp(P, 1) + (size_t)row0 * 1024; \
            _Pragma("unroll") for (int ks = 0; ks < 2; ++ks) acc = MFMA16(*(const bf16x8*)(VT + (16 * vtl + fr) * 72 + 32 * ks + 8 * fq), *(const bf16x8*)(Pm + (16 * tt + fr) * 72 + 32 * ks + 8 * fq), acc); \
            _Pragma("unroll") for (int ks = 0; ks < 4; ++ks) acc = MFMA16(*(const bf16x8*)(ST + (16 * vtl + fr) * 136 + 32 * ks + 8 * fq), *(const bf16x8*)(Qt + (16 * tt + fr) * 136 + 32 * ks + 8 * fq), acc); \
            uint2 w; w.x = pk2(acc[0], acc[1]); w.y = pk2(acc[2], acc[3]); *(uint2*)(oo + ob_) = w; } \
        { bf16x8 ka[2]; \
            _Pragma("unroll") for (int ks = 0; ks < 2; ++ks) ka[ks] = *(const bf16x8*)(KtT + (16 * wid + fr) * 72 + 32 * ks + 8 * fq); \
            const f32x4 dc4 = erc * elc; \
            _Pragma("unroll") for (int vt = 0; vt < 2; ++vt) { f32x4 T = (f32x4){0.f, 0.f, 0.f, 0.f}; \
                _Pragma("unroll") for (int ks = 0; ks < 2; ++ks) T = MFMA16(ka[ks], *(const bf16x8*)(VT + (16 * vt + fr) * 72 + 32 * ks + 8 * fq), T); \
                S[vt] = dc4 * S[vt] + elc * T; } } \
        LBAR(); \
        _Pragma("unroll") for (int vt = 0; vt < 2; ++vt) { const f32x4 sv = S[vt] * ERN; uint2 w; w.x = pk2(sv[0], sv[1]); w.y = pk2(sv[2], sv[3]); *(uint2*)(ST + (16 * vt + fr) * 136 + 16 * wid + 4 * fq) = w; } \
    } while (0)
    SCAN_LOAD(scan_row0(0, b, dir), qa_, ka_, va_, era, ela);
    SCAN_LOAD(scan_row0(1, b, dir), qb_r, kb_r, vb_r, erb, elb);
    __syncthreads();
    for (int c = 0; c < 68; c += 2) {
        SCAN_ITER(c, qa_, ka_, va_, era, ela, erb);
        SCAN_ITER(c + 1, qb_r, kb_r, vb_r, erb, elb, era);
    }
#undef SCAN_ITER
}
#undef SCAN_LOAD
DI void readout_phase(const Params& P, int l, int nrows, int dry, int s_of, int s_ob, int s_og) {
    const int tid_ = ltid(); const int lane = tid_ & 63, wid = tid_ >> 6;
    bf16_t* of = slotp(P, s_of); const bf16_t* og = slotp(P, s_og); const float* nw = P.in[13] + l * 128 + 16 * (lane & 7);
    for (int row = blockIdx.x * 8 + wid; row < nrows; row += gridDim.x * 8) {
        const size_t off = (size_t)row * 1024 + 16 * lane; float o[16], g[16]; const bf16_t* obr = xrow16(P, row) + 1024 + 16 * lane;
#pragma unroll
        for (int h = 0; h < 2; ++h) { const uint4 a = *(const uint4*)(of + off + 8 * h), bb = *(const uint4*)(obr + 8 * h), gg = *(const uint4*)(og + off + 8 * h);
            o[8 * h + 0] = bflo(a.x) + bflo(bb.x); o[8 * h + 1] = bfhi(a.x) + bfhi(bb.x); o[8 * h + 2] = bflo(a.y) + bflo(bb.y); o[8 * h + 3] = bfhi(a.y) + bfhi(bb.y);
            o[8 * h + 4] = bflo(a.z) + bflo(bb.z); o[8 * h + 5] = bfhi(a.z) + bfhi(bb.z); o[8 * h + 6] = bflo(a.w) + bflo(bb.w); o[8 * h + 7] = bfhi(a.w) + bfhi(bb.w);
            g[8 * h + 0] = bflo(gg.x); g[8 * h + 1] = bfhi(gg.x); g[8 * h + 2] = bflo(gg.y); g[8 * h + 3] = bfhi(gg.y); g[8 * h + 4] = bflo(gg.z); g[8 * h + 5] = bfhi(gg.z); g[8 * h + 6] = bflo(gg.w); g[8 * h + 7] = bfhi(gg.w); }
        float ss = 0.f;
#pragma unroll
        for (int j = 0; j < 16; ++j) ss += o[j] * o[j];
        ss += __shfl_xor(ss, 1); ss += __shfl_xor(ss, 2); ss += __shfl_xor(ss, 4);
        const float rstd = __builtin_amdgcn_rsqf(ss * (1.0f / 128.0f) + 1e-6f);
        float y[16];
#pragma unroll
        for (int j = 0; j < 16; ++j) y[j] = o[j] * rstd * nw[j] * g[j];
#pragma unroll
        for (int h = 0; h < 2; ++h) { uint4 w; w.x = pk2(y[8 * h], y[8 * h + 1]); w.y = pk2(y[8 * h + 2], y[8 * h + 3]); w.z = pk2(y[8 * h + 4], y[8 * h + 5]); w.w = pk2(y[8 * h + 6], y[8 * h + 7]); *(uint4*)((dry ? slotp(P, 6) : of) + off + 8 * h) = w; }
    }
}

DI void sgu_phase(const Params& P, unsigned char* lds, int l, int nrows, int dry, int s_u, int s_v) {
    const int tid = ltid(), lane = tid & 63, wid = tid >> 6, fr = lane & 15, fq = lane >> 4;
    float* stat = (float*)lds; unsigned short* vnT = (unsigned short*)(lds + 1024);
    bf16_t* up = slotp(P, s_u); const bf16_t* vp = slotp(P, s_v); const float* lnw = P.in[8] + l * 1024; const float* lnb = P.in[9] + l * 1024;
    const bf16_t* Ws = (const bf16_t*)(P.ws + WS_WS); const float* bs = P.in[11] + l * 1024;
    bf16_t* yout = dry ? slotp(P, 6) : up; const int nitems = (nrows / 128) * 8;
    const int s_ = tid >> 2, dq = (tid & 3) * 32;
    uint4 vr0, vr1, vr2, vr3; float4 sq[8];
#define SGU_FETCH(it) do { const int r0_ = ((it) >> 3) * 128, g_ = (it) & 7; const bf16_t* vs_ = vp + (size_t)(r0_ + s_) * 1024 + g_ * 128 + dq; vr0 = *(const uint4*)vs_; vr1 = *(const uint4*)(vs_ + 8); vr2 = *(const uint4*)(vs_ + 16); vr3 = *(const uint4*)(vs_ + 24); \
        if (tid < 128) { const float4* sp_ = (const float4*)((const float*)(P.ws + WS_VEC) + (size_t)(r0_ + tid) * 32); _Pragma("unroll") for (int i = 0; i < 8; ++i) sq[i] = sp_[i]; } } while (0)
    int item = blockIdx.x;
    if (item < nitems) SGU_FETCH(item);
    for (; item < nitems; item += gridDim.x) {
        const int r0 = (item >> 3) * 128, g = item & 7, t = 16 * wid + fr;
        bf16x8 a[4]; uint2 uu[8];
#pragma unroll
        for (int ks = 0; ks < 4; ++ks) a[ks] = *(const bf16x8*)(Ws + g * 16384 + (16 * wid + fr) * 128 + 32 * ks + 8 * fq);
#pragma unroll
        for (int dt = 0; dt < 8; ++dt) uu[dt] = *(const uint2*)(up + (size_t)(r0 + t) * 1024 + g * 128 + 16 * dt + 4 * fq);
        const float bt = bs[g * 128 + t];
        if (tid < 128) { float t1 = 0.f, t2 = 0.f;
#pragma unroll
            for (int i = 0; i < 8; ++i) { t1 += sq[i].x; t2 += sq[i].y; t1 += sq[i].z; t2 += sq[i].w; }
            const float mean = t1 * (1.0f / 1024.0f); const float var = t2 * (1.0f / 1024.0f) - mean * mean;
            stat[2 * tid] = mean; stat[2 * tid + 1] = __builtin_amdgcn_rsqf(fmaxf(var, 0.f) + 1e-5f); }
        __syncthreads();
        { const float mean = stat[2 * s_], rstd = stat[2 * s_ + 1]; const unsigned ww[16] = {vr0.x, vr0.y, vr0.z, vr0.w, vr1.x, vr1.y, vr1.z, vr1.w, vr2.x, vr2.y, vr2.z, vr2.w, vr3.x, vr3.y, vr3.z, vr3.w};
#pragma unroll
            for (int e = 0; e < 32; ++e) { const int d = dq + e, ch = g * 128 + d; const float x = (e & 1) ? bfhi(ww[e >> 1]) : bflo(ww[e >> 1]);
                vnT[d * 136 + (s_ ^ ((tid & 3) << 4))] = f2bf((x - mean) * rstd * lnw[ch] + lnb[ch]); } }
        __syncthreads();
        if (item + (int)gridDim.x < nitems) SGU_FETCH(item + (int)gridDim.x);
#pragma unroll
        for (int dt = 0; dt < 8; ++dt) { f32x4 acc = (f32x4){0.f, 0.f, 0.f, 0.f};
#pragma unroll
            for (int ks = 0; ks < 4; ++ks) acc = MFMA16(*(const bf16x8*)(vnT + (16 * dt + fr) * 136 + ((32 * ks + 8 * fq) ^ (((dt >> 1) & 3) << 4))), a[ks], acc);
            const size_t off = (size_t)(r0 + t) * 1024 + g * 128 + 16 * dt + 4 * fq; uint2 w;
            w.x = pk2(bflo(uu[dt].x) * (acc[0] + bt), bfhi(uu[dt].x) * (acc[1] + bt)); w.y = pk2(bflo(uu[dt].y) * (acc[2] + bt), bfhi(uu[dt].y) * (acc[3] + bt)); *(uint2*)(yout + off) = w; }
        __syncthreads();
    }
#undef SGU_FETCH
}

DI void conv_phase(const Params& P, int l, int nrows, int dry) {
    const bf16_t* a = (const bf16_t*)(P.ws + WS_ACT); bf16_t* v2 = (bf16_t*)(P.ws + WS_ACT) + (size_t)RT * DFF;
    const float* cw = P.in[19] + (size_t)l * 9 * DFF; const float* cb = P.in[20] + (size_t)l * DFF;
    const int tid0 = blockIdx.x * 512 + ltid();
    for (int idx = tid0; idx < NBATCH * 64 * 4 * (DFF / 8); idx += gridDim.x * 512) {
        const int c8 = idx % (DFF / 8), r = idx / (DFF / 8), seg = r & 3, gy = (r >> 2) & 63, b = r >> 8, c = c8 * 8, gx0 = seg * 16, rb = b * 4096 + gy * 64;
        float w[9][8], bias[8], win[3][3][8];
#pragma unroll
        for (int t = 0; t < 9; ++t) { const float4 w0 = *(const float4*)(cw + t * DFF + c), w1 = *(const float4*)(cw + t * DFF + c + 4); w[t][0] = w0.x; w[t][1] = w0.y; w[t][2] = w0.z; w[t][3] = w0.w; w[t][4] = w1.x; w[t][5] = w1.y; w[t][6] = w1.z; w[t][7] = w1.w; }
        { const float4 b0 = *(const float4*)(cb + c), b1 = *(const float4*)(cb + c + 4); bias[0] = b0.x; bias[1] = b0.y; bias[2] = b0.z; bias[3] = b0.w; bias[4] = b1.x; bias[5] = b1.y; bias[6] = b1.z; bias[7] = b1.w; }
#define CONV_FETCH(gx) do { _Pragma("unroll") for (int dy = 0; dy < 3; ++dy) { const int yy = gy + dy - 1; const bool ok = (unsigned)yy < 64u && (unsigned)(gx) < 64u; \
            const int rr_ = ok ? rb + (dy - 1) * 64 + (gx) : rb; pf[dy] = *(const uint4*)(a + (size_t)rr_ * DFF + c); if (!ok) pf[dy] = make_uint4(0u, 0u, 0u, 0u); } } while (0)
#define CONV_UNPACK(slot) do { _Pragma("unroll") for (int dy = 0; dy < 3; ++dy) { const uint4 av = pf[dy]; \
            win[dy][slot][0] = bflo(av.x); win[dy][slot][1] = bfhi(av.x); win[dy][slot][2] = bflo(av.y); win[dy][slot][3] = bfhi(av.y); win[dy][slot][4] = bflo(av.z); win[dy][slot][5] = bfhi(av.z); win[dy][slot][6] = bflo(av.w); win[dy][slot][7] = bfhi(av.w); } } while (0)
        uint4 pf[3]; uint4 vvn;
        CONV_FETCH(gx0 - 1); CONV_UNPACK(0); CONV_FETCH(gx0); CONV_UNPACK(1);
        CONV_FETCH(gx0 + 1); vvn = *(const uint4*)(v2 + (size_t)(rb + gx0) * DFF + c);
#pragma unroll
        for (int st = 0; st < 16; ++st) { const int gx = gx0 + st; const int s0 = st % 3, s1 = (st + 1) % 3, s2 = (st + 2) % 3;
            CONV_UNPACK(s2); const uint4 vv = vvn;
            if (st < 15) { CONV_FETCH(gx + 2); vvn = *(const uint4*)(v2 + (size_t)(rb + gx + 1) * DFF + c); }
            float acc[8];
#pragma unroll
            for (int j = 0; j < 8; ++j) { float t = bias[j];
#pragma unroll
                for (int dy = 0; dy < 3; ++dy) t += win[dy][s0][j] * w[dy * 3][j] + win[dy][s1][j] * w[dy * 3 + 1][j] + win[dy][s2][j] * w[dy * 3 + 2][j];
                acc[j] = t; }
            const size_t off = (size_t)(rb + gx) * DFF + c; uint4 o;
            o.x = pk2(gelu_t(acc[0]) * bflo(vv.x), gelu_t(acc[1]) * bfhi(vv.x)); o.y = pk2(gelu_t(acc[2]) * bflo(vv.y), gelu_t(acc[3]) * bfhi(vv.y));
            o.z = pk2(gelu_t(acc[4]) * bflo(vv.z), gelu_t(acc[5]) * bfhi(vv.z)); o.w = pk2(gelu_t(acc[6]) * bflo(vv.w), gelu_t(acc[7]) * bfhi(vv.w));
            *(uint4*)(dry ? (bf16_t*)(P.ws + WS_ACT) + (size_t)RT * DFF * 2 + (off & 0xFFFFF8) : v2 + off) = o; }
#undef CONV_FETCH
#undef CONV_UNPACK
    }
    for (int idx = tid0; idx < (nrows - RL) * (DFF / 8); idx += gridDim.x * 512) {
        const int row = RL + idx / (DFF / 8), c = (idx % (DFF / 8)) * 8, t = (row - RL) & 255;
        float acc[8]; { const float4 b0 = *(const float4*)(cb + c), b1 = *(const float4*)(cb + c + 4); acc[0] = b0.x; acc[1] = b0.y; acc[2] = b0.z; acc[3] = b0.w; acc[4] = b1.x; acc[5] = b1.y; acc[6] = b1.z; acc[7] = b1.w; }
        for (int dx = -1; dx <= 1; ++dx) { if ((unsigned)(t + dx) >= 256u) continue;
            const uint4 av = *(const uint4*)(a + (size_t)(row + dx) * DFF + c); const float4 w0 = *(const float4*)(cw + (4 + dx) * DFF + c), w1 = *(const float4*)(cw + (4 + dx) * DFF + c + 4);
            acc[0] += bflo(av.x) * w0.x; acc[1] += bfhi(av.x) * w0.y; acc[2] += bflo(av.y) * w0.z; acc[3] += bfhi(av.y) * w0.w; acc[4] += bflo(av.z) * w1.x; acc[5] += bfhi(av.z) * w1.y; acc[6] += bflo(av.w) * w1.z; acc[7] += bfhi(av.w) * w1.w; }
        const size_t off = (size_t)row * DFF + c; const uint4 vv = *(const uint4*)(v2 + off); uint4 o;
        o.x = pk2(gelu_t(acc[0]) * bflo(vv.x), gelu_t(acc[1]) * bfhi(vv.x)); o.y = pk2(gelu_t(acc[2]) * bflo(vv.y), gelu_t(acc[3]) * bfhi(vv.y));
        o.z = pk2(gelu_t(acc[4]) * bflo(vv.z), gelu_t(acc[5]) * bfhi(vv.z)); o.w = pk2(gelu_t(acc[6]) * bflo(vv.w), gelu_t(acc[7]) * bfhi(vv.w));
        *(uint4*)(dry ? (bf16_t*)(P.ws + WS_ACT) + (size_t)RT * DFF * 2 + (off & 0xFFFFF8) : v2 + off) = o;
    }
}

DI void final_phase(const Params& P, int dry) {
    const int tid_ = ltid(); const int lane = tid_ & 63, wid = tid_ >> 6; const float* fw = P.in[22]; const int nw_tot = gridDim.x * 8;
    for (int rowb = blockIdx.x * 8 + wid; rowb < RL; rowb += 2 * nw_tot) {
        float4 v[2][4]; const int rows[2] = {rowb, rowb + nw_tot};
#pragma unroll
        for (int r = 0; r < 2; ++r) { const int row = rows[r] < RL ? rows[r] : rowb; const uint2* xb = (const uint2*)((const bf16_t*)P.out + (size_t)row * 2048);
#pragma unroll
            for (int q = 0; q < 4; ++q) { const uint2 w = xb[q * 64 + lane]; v[r][q] = make_float4(bflo(w.x), bfhi(w.x), bflo(w.y), bfhi(w.y)); } }
        asm volatile("s_waitcnt vmcnt(0)" ::: "memory");
#pragma unroll
        for (int r = 0; r < 2; ++r) { const int row = rows[r]; if (row >= RL) continue; float4* xr = (float4*)(P.out + (size_t)row * 1024); float ss = 0.f;
#pragma unroll
            for (int q = 0; q < 4; ++q) ss += v[r][q].x * v[r][q].x + v[r][q].y * v[r][q].y + v[r][q].z * v[r][q].z + v[r][q].w * v[r][q].w;
            ss = wave_sum(ss); const float rstd = __builtin_amdgcn_rsqf(ss * (1.0f / 1024.0f) + 1e-6f);
#pragma unroll
            for (int q = 0; q < 4; ++q) { const float4 w = *(const float4*)(fw + 4 * (q * 64 + lane)); float4 o; o.x = v[r][q].x * rstd * w.x; o.y = v[r][q].y * rstd * w.y; o.z = v[r][q].z * rstd * w.z; o.w = v[r][q].w * rstd * w.w; if (!dry) xr[q * 64 + lane] = o; } }
    }
}

constexpr int N_PHASES = 26;
#ifndef PROBE_MASK
#define PROBE_MASK 0
#endif
#define PR(n) (((PROBE_MASK) >> (n)) & 1)
__global__ void __launch_bounds__(512) mega_fwd(Params P) {
    extern __shared__ __attribute__((aligned(16))) unsigned char lds[];
    cg::grid_group grid = cg::this_grid();
#define IN(k) (P.ph_lo <= (k) && (k) < P.ph_hi)
#define SEAM(k) do { if (IN(k) && IN((k) + 1)) { xcd_barrier(xb); if constexpr (PR(15)) xcd_barrier(xb); } } while (0)
    volatile LAS3 unsigned* st_words = (volatile LAS3 unsigned*)((LAS3 unsigned char*)lds + (LDS_BYTES - 16));
    if (threadIdx.x < 4) st_words[threadIdx.x] = 0u;
    __syncthreads();
    unsigned* barw = (unsigned*)(P.ws + WS_BAR);
    if (IN(0)) { if constexpr (PR(12)) { phase_prologue(P, lds); __syncthreads(); } phase_prologue(P, lds); }
    if (P.ph_lo < 0) grid.sync();
    XcdBarrier xb = xcd_barrier_post(barw, st_words);
    SEAM(0);
    const bf16_t* WinT = (const bf16_t*)(P.ws + WS_WIN);
    for (int l = 0; l < 2; ++l) {
        const int base = 1 + 12 * l; const int MP = (l == 1) ? RL : RT; const float* modl = (const float*)(P.ws + WS_MOD) + (size_t)l * 5 * 6144;
        if (IN(base + 0)) { norm_phase(P, l, 0, slotp(P, 0), RT); }
        SEAM(base + 0);
        if (IN(base + 1)) { Epi<M_H> E{}; E.o0 = slotp(P, 1); E.o1 = slotp(P, 2); E.o2 = slotp(P, 3); E.o3 = slotp(P, 4); E.gate = (const float*)(P.ws + WS_LB) + l * 2048; if constexpr (PR(1)) run_gemm<M_H>(lds, slotp(P, 0), WinT, RT, 4096, 1024, E); run_gemm<M_H>(lds, slotp(P, 0), WinT, RT, 4096, 1024, E);
            __syncthreads(); convert_weights(P, l, lds, 4, 64); }
        SEAM(base + 1);
        if (IN(base + 2)) scanprep_phase(P, lds, l);
        SEAM(base + 2);
        if (IN(base + 3)) scan_phase(P, lds, l);
        SEAM(base + 3);
        if (IN(base + 4)) { Epi<M_B> E{}; E.o0 = slotp(P, 3); E.o1 = slotp(P, 4); E.o2 = slotp(P, 5); E.o3 = slotp(P, 6); E.gate = (const float*)(P.ws + WS_VEC);
            if constexpr (PR(3)) run_gemm<M_B>(lds, slotp(P, 0), WinT + (size_t)4096 * 1024, MP, 5120, 1024, E); run_gemm<M_B>(lds, slotp(P, 0), WinT + (size_t)4096 * 1024, MP, 5120, 1024, E); }
        SEAM(base + 4);
        if (IN(base + 5)) { if constexpr (PR(4)) { readout_phase(P, l, MP, 1, 1, 0, 5); sgu_phase(P, lds, l, MP, 1, 3, 4); } if (blockIdx.x & 8) { sgu_phase(P, lds, l, MP, 0, 3, 4); readout_phase(P, l, MP, 0, 1, 0, 5); } else { readout_phase(P, l, MP, 0, 1, 0, 5); sgu_phase(P, lds, l, MP, 0, 3, 4); } }
        SEAM(base + 5);
        if (IN(base + 6)) {
            const bool early_ = (blockIdx.x & 8) != 0;
            if (l == 0 && early_) { ctx_ab_gemm(P, lds); __syncthreads(); convert_weights(P, 1, lds, 3, 0); __syncthreads(); }
            { Epi<M_WA> E{}; E.o0 = slotp(P, 5); E.g0 = slotp(P, 6); if constexpr (PR(6)) run_gemm<M_WA>(lds, slotp(P, 3), (const bf16_t*)(P.ws + WS_WA), MP, 1024, 1024, E); run_gemm<M_WA>(lds, slotp(P, 3), (const bf16_t*)(P.ws + WS_WA), RL, 1024, 1024, E); }
            { Epi<M_WB> E{}; E.o0 = slotp(P, 2); E.g0 = (const bf16_t*)((const unsigned char*)slotp(P, 6) + 1024); E.g1 = slotp(P, 5); if constexpr (PR(6)) run_gemm<M_WB>(lds, slotp(P, 1), (const bf16_t*)(P.ws + WS_WB), MP, 1024, 1024, E); run_gemm<M_WB>(lds, slotp(P, 1), (const bf16_t*)(P.ws + WS_WB), RL, 1024, 1024, E); }
            if (l == 0 && !early_) { ctx_ab_gemm(P, lds); __syncthreads(); convert_weights(P, 1, lds, 3, 0); }
        }
        SEAM(base + 6);
        if (IN(base + 7)) { Epi<M_RES> E{}; E.xl = P.out; E.xc = (float*)(P.ws + WS_CTX); E.gate = modl + 2 * 1024; E.sl = l == 0 ? P.in[0] : nullptr; E.sc = l == 0 ? P.in[2] : nullptr; run_gemm<M_RES>(lds, slotp(P, 2), (const bf16_t*)(P.ws + WS_WO), RL, 1024, 1024, E);
            if (l == 0) ctx_res_gemm(P, lds, slotp(P, 2) + (size_t)RL * 1024, 1024, (const bf16_t*)(P.ws + WS_WO), 1024, modl + 4 * 6144 + 2 * 1024, P.in[2]); }
        SEAM(base + 7);
        if (IN(base + 8)) { if constexpr (PR(8)) norm_phase(P, l, 1, slotp(P, 6), MP); norm_phase(P, l, 1, slotp(P, 6), MP); }
        SEAM(base + 8);
        if (IN(base + 9)) { Epi<M_UP> E{}; E.o0 = (bf16_t*)(P.ws + WS_ACT); E.o1 = (bf16_t*)(P.ws + WS_ACT) + (size_t)RT * DFF; if constexpr (PR(9)) run_gemm<M_UP>(lds, slotp(P, 6), (const bf16_t*)(P.ws + WS_WUP), MP, 2 * DFF, 1024, E); run_gemm<M_UP>(lds, slotp(P, 6), (const bf16_t*)(P.ws + WS_WUP), MP, 2 * DFF, 1024, E); }
        SEAM(base + 9);
        if (IN(base + 10)) { if constexpr (PR(10)) conv_phase(P, l, MP, 1); conv_phase(P, l, MP, 0); }
        SEAM(base + 10);
        if (IN(base + 11)) { Epi<M_RES> E{}; E.xl = P.out; E.xc = (float*)(P.ws + WS_CTX); E.gate = modl + 5 * 1024; E.sl = nullptr; E.sc = nullptr; run_gemm<M_RES>(lds, (const bf16_t*)(P.ws + WS_ACT) + (size_t)RT * DFF, (const bf16_t*)(P.ws + WS_WDN), RL, 1024, DFF, E);
            if (l == 0) { ctx_res_gemm(P, lds, (const bf16_t*)(P.ws + WS_ACT) + (size_t)RT * DFF + (size_t)RL * DFF, DFF, (const bf16_t*)(P.ws + WS_WDN), DFF, modl + 4 * 6144 + 5 * 1024, nullptr); } }
        SEAM(base + 11);
    }
    if (IN(25)) final_phase(P, 0);
#undef IN
#undef SEAM
}

#ifndef MULTI_LAUNCH
#define MULTI_LAUNCH 0
#endif
extern "C" void kernel_launch(void* const* d_in, const int* in_sizes, int n_in, void* d_out, int out_size, void* d_ws, size_t ws_size, hipStream_t stream) {
    static int grid = 0;
    if (grid == 0) {
        if (n_in != 23 || out_size != RL * 1024 || ws_size < WS_END) { fprintf(stderr, "kernel_launch: unexpected problem (n_in %d out %d ws %zu need %zu)\n", n_in, out_size, ws_size, (size_t)WS_END); grid = -1; return; }
        int dev = 0, cus = 0, per_cu = 0;
        hipGetDevice(&dev); hipDeviceGetAttribute(&cus, hipDeviceAttributeMultiprocessorCount, dev);
        if (hipFuncSetAttribute((const void*)mega_fwd, hipFuncAttributeMaxDynamicSharedMemorySize, LDS_BYTES) != hipSuccess) { fprintf(stderr, "kernel_launch: hipFuncSetAttribute failed\n"); grid = -1; return; }
        if (hipOccupancyMaxActiveBlocksPerMultiprocessor(&per_cu, (const void*)mega_fwd, 512, LDS_BYTES) != hipSuccess || per_cu < 1) { fprintf(stderr, "kernel_launch: occupancy query says %d blocks per CU\n", per_cu); (void)hipGetLastError(); per_cu = 1; }
        grid = cus;
        if (grid < 256) { fprintf(stderr, "kernel_launch: needs 256 CUs\n"); grid = -1; return; } grid = 256;
    }
    if (grid < 0) return;
    Params p{};
    for (int i = 0; i < 23; ++i) p.in[i] = (const float*)d_in[i];
    p.out = (float*)d_out; p.ws = (unsigned char*)d_ws;
#if MULTI_LAUNCH
    for (int k = 0; k < N_PHASES; ++k) { p.ph_lo = k; p.ph_hi = k + 1; hipLaunchKernelGGL(mega_fwd, dim3(grid), dim3(512), LDS_BYTES, stream, p); }
#else
    p.ph_lo = 0; p.ph_hi = N_PHASES;
    if (hipMemsetAsync((char*)d_ws + WS_BAR, 0, XCD_BAR_WORDS * 4, stream) != hipSuccess) { fprintf(stderr, "kernel_launch: memset of the barrier words failed\n"); return; }
    void* args[] = {&p};
    hipError_t e = hipLaunchCooperativeKernel((const void*)mega_fwd, dim3(grid), dim3(512), args, LDS_BYTES, stream);
    if (e != hipSuccess) fprintf(stderr, "cooperative launch failed: %s (grid %d)\n", hipGetErrorString(e), grid);
#endif
}
```

```cpp
#include <hip/hip_runtime.h>
#include <hip/hip_cooperative_groups.h>
#include <cstdio>
namespace cg = cooperative_groups;

constexpr int DM = 1024, NBATCH = 4, SEQL = 4096, CTXL = 256, RL = NBATCH * SEQL, RC = NBATCH * CTXL, RT = RL + RC;
constexpr int DIN = 9216, DFF = 2816;
constexpr size_t USLOT = (size_t)RT * 1024 * 2;
constexpr size_t WS_WIN = 0;
constexpr size_t WS_WA = WS_WIN + (size_t)DIN * 1024 * 2;
constexpr size_t WS_WB = WS_WA + 1024 * 1024 * 2;
constexpr size_t WS_WO = WS_WB + 1024 * 1024 * 2;
constexpr size_t WS_WUP = WS_WO + 1024 * 1024 * 2;
constexpr size_t WS_WDN = WS_WUP + (size_t)2 * DFF * 1024 * 2;
constexpr size_t WS_WS = WS_WDN + (size_t)1024 * DFF * 2;
constexpr size_t WS_MOD = WS_WS + 8 * 128 * 128 * 2;
constexpr size_t WS_LB = WS_MOD + 2 * 5 * 6144 * 4;
constexpr size_t WS_CTX = WS_LB + 2 * 2048 * 4;
constexpr size_t WS_ACT = WS_CTX + (size_t)RC * 1024 * 4;
constexpr size_t WS_BAR = WS_ACT + 7 * USLOT;
constexpr size_t WS_VEC = WS_BAR + 16384;
constexpr size_t WS_STAT = WS_VEC + (size_t)272 * 8 * 2 * 256 * 4;
constexpr size_t WS_END = WS_STAT + (size_t)RT * 2 * 4;
constexpr int LDS_BYTES = 137744;

#define DI __device__ __forceinline__
DI float bf2f(unsigned short u) { return __uint_as_float((unsigned)u << 16); }
DI float bflo(unsigned w) { return __uint_as_float(w << 16); }
DI float bfhi(unsigned w) { return __uint_as_float(w & 0xffff0000u); }
DI unsigned short f2bf(float f) { unsigned u = __float_as_uint(f); u += 0x7fffu + ((u >> 16) & 1u); return (unsigned short)(u >> 16); }
typedef __bf16 bf16v2_t __attribute__((ext_vector_type(2))); typedef float f32v2_t __attribute__((ext_vector_type(2)));
DI unsigned pk2(float lo, float hi) { const f32v2_t f = {lo, hi}; const bf16v2_t h = __builtin_convertvector(f, bf16v2_t); return __builtin_bit_cast(unsigned, h); }
DI unsigned pkh2(float a, float b) { _Float16 x = (_Float16)a, y = (_Float16)b; return (unsigned)__builtin_bit_cast(unsigned short, x) | ((unsigned)__builtin_bit_cast(unsigned short, y) << 16); }
DI float h2f(unsigned short u) { return (float)__builtin_bit_cast(_Float16, u); }
DI float fexp(float x) { return __builtin_amdgcn_exp2f(x * 1.44269504089f); }
DI float flog(float x) { return __builtin_amdgcn_logf(x) * 0.69314718056f; }
DI float sigm(float x) { return __builtin_amdgcn_rcpf(1.0f + fexp(-x)); }
DI float silu_f(float x) { return x * sigm(x); }
DI float gelu_t(float x) { return x * sigm(1.59576912161f * (x + 0.044715f * x * x * x)); }
DI float wave_sum(float v) { for (int o = 32; o >= 1; o >>= 1) v += __shfl_xor(v, o); return v; }

namespace pg8 {
#define PG8_LAS __attribute__((address_space(3)))
typedef unsigned short bf16_t;
typedef short bf16x8 __attribute__((ext_vector_type(8)));
typedef float f32x4 __attribute__((ext_vector_type(4)));
typedef unsigned u32x4 __attribute__((ext_vector_type(4)));
constexpr int BM = 256, BK = 64, HALF = 128, HTB = HALF * BK * 2  , STAGE_BYTES = 8 * HTB, NXCD = 8, WGM = 8;

__host__ __device__ __forceinline__ int lds_byte(int r, int c) { const int st = (r >> 4) * 2 + (c >> 5), rr = r & 15, cc = c & 31, ob = rr * 64 + cc * 2; return st * 1024 + (ob ^ (((ob >> 9) & 1) << 5)); }
__host__ __device__ __forceinline__ void stage_rc(int b, int& R, int& C) { const int st = b / 1024, sb = b % 1024, swz = sb ^ (((sb >> 9) & 1) << 5); R = (st >> 1) * 16 + swz / 64; C = (st & 1) * 32 + (swz % 64) / 2; }
__host__ __device__ __forceinline__ int perm32(int rho) { const int n = rho >> 4, i = rho & 15; return 8 * (i >> 2) + 4 * n + (i & 3); }

struct Unit { int pm, pn; };
struct Gemm { const bf16_t* A; const bf16_t* Bt; int M, N, K; };

struct StaticOrder {
    int nM, nN, nwg, G, c;
    __host__ __device__ void init(int M, int N, int G_, int c_) { nM = M / BM; nN = N / BM; nwg = nM * nN; G = G_; c = c_; }
    __host__ __device__ bool next(int i, Unit& u) const {
        const long L = (long)i * G + c; if (L >= nwg) return false;
        int wgid = (int)L; { const int q = nwg / NXCD, r = nwg % NXCD, xcd = wgid % NXCD, off = wgid / NXCD; wgid = (xcd < r ? xcd * (q + 1) : r * (q + 1) + (xcd - r) * q) + off; }
        const int nig = WGM * nN, gid = wgid / nig, fm = gid * WGM, gsz = (nM - fm) < WGM ? (nM - fm) : WGM;
        u.pm = fm + ((wgid % nig) % gsz); u.pn = (wgid % nig) / gsz; return true;
    }
    __device__ __forceinline__ void a_ready(const Unit&) const {}
    __device__ __forceinline__ void done(const Unit&) const {}
};
__device__ __forceinline__ unsigned cvt_pk_bf16(float lo, float hi) { unsigned r; asm volatile("v_cvt_pk_bf16_f32 %0, %1, %2" : "=v"(r) : "v"(lo), "v"(hi)); return r; }
typedef float f32x2 __attribute__((ext_vector_type(2)));
template <class Epi, class Sched, bool ALIGN_EPI = false, bool SP2 = false>
__device__ __forceinline__ void gemm_phase(PG8_LAS unsigned char* lds, const Gemm g, const Sched& S, const Epi& E) {
    int tid = threadIdx.x; asm volatile("" : "+v"(tid)); const int wid = __builtin_amdgcn_readfirstlane(tid >> 6), lane = tid & 63, wr = wid >> 2, wc = wid & 3, fr = lane & 15, fq = lane >> 4;
    const int K = g.K, nt = K / BK;
    unsigned voffA[2], voffB[2];
#pragma unroll
    for (int i = 0; i < 2; ++i) { int R, C; stage_rc(tid * 16 + i * 8192, R, C); const int Rb = Epi::PERM ? ((R & ~31) + perm32(R & 31)) : R;
        voffA[i] = (unsigned)(R * K + C) * 2u; voffB[i] = (unsigned)(Rb * K + C) * 2u; }
    const size_t kstep = (size_t)(BK * 2);
    const size_t hstep = (size_t)HALF * K * 2;
    const size_t tstep = 2 * hstep;
    const unsigned ldsw = (unsigned)wid * 1024u;
    const int aoff = lds_byte(wr * 64 + fr, fq * 8), boff = lds_byte(wc * 32 + fr, fq * 8);
#define PG8_SA(b, h) (((b) * 2 + (h)) * HTB)
#define PG8_SB(b, h) ((4 + (b) * 2 + (h)) * HTB)
#define PG8_STAGE(bufoff, gbase, voff) do { _Pragma("unroll") for (int _i = 0; _i < 2; ++_i) \
        __builtin_amdgcn_global_load_lds((const unsigned*)((const char*)(gbase) + (voff)[_i]), (PG8_LAS unsigned*)(lds + (bufoff) + ldsw + _i * 8192), 16, 0, 0); } while (0)
#define PG8_LDA(dst, b, h) do { _Pragma("unroll") for (int m = 0; m < 4; ++m) _Pragma("unroll") for (int k = 0; k < 2; ++k) dst[m][k] = *(const PG8_LAS bf16x8*)(lds + PG8_SA(b, h) + aoff + m * 2048 + k * 1024); } while (0)
#define PG8_LDB(dst, b, h) do { _Pragma("unroll") for (int n = 0; n < 2; ++n) _Pragma("unroll") for (int k = 0; k < 2; ++k) dst[n][k] = *(const PG8_LAS bf16x8*)(lds + PG8_SB(b, h) + boff + n * 2048 + k * 1024); } while (0)
#define PG8_MMA(ai, bj, At, Bt) do { __builtin_amdgcn_s_setprio(1); _Pragma("unroll") for (int m = 0; m < 4; ++m) _Pragma("unroll") for (int n = 0; n < 2; ++n) _Pragma("unroll") for (int k = 0; k < 2; ++k) \
        acc[ai][bj][m][n] = __builtin_amdgcn_mfma_f32_16x16x32_bf16(Bt[n][k], At[m][k], acc[ai][bj][m][n], 0, 0, 0); __builtin_amdgcn_s_setprio(0); } while (0)
#define PG8_WAIT_V(n) asm volatile("s_waitcnt vmcnt(" #n ")" ::: "memory")
#define PG8_WAIT_L(n) asm volatile("s_waitcnt lgkmcnt(" #n ")" ::: "memory")
#define PG8_BAR __builtin_amdgcn_s_barrier()
#define PG8_SCHED __builtin_amdgcn_sched_barrier(0)
    Unit cur, nxt; int ui = 0;
    if (!S.next(0, cur)) return;
    f32x4 acc[2][2][4][2];
#pragma unroll
    for (int a = 0; a < 2; ++a)
#pragma unroll
        for (int b = 0; b < 2; ++b)
#pragma unroll
            for (int m = 0; m < 4; ++m)
#pragma unroll
                for (int n = 0; n < 2; ++n) acc[a][b][m][n] = (f32x4){0.f, 0.f, 0.f, 0.f};
    bf16x8 At[4][2], B0[2][2], B1[2][2];
    const char* cA = (const char*)g.A + (size_t)cur.pm * tstep; const char* cB = (const char*)g.Bt + (size_t)cur.pn * tstep;
    S.a_ready(cur);
    if constexpr (SP2) {
        PG8_STAGE(PG8_SB(0, 0), cB, voffB); PG8_STAGE(PG8_SB(0, 1), cB + hstep, voffB); PG8_STAGE(PG8_SA(0, 0), cA, voffA); PG8_STAGE(PG8_SA(0, 1), cA + hstep, voffA);
        if (wr == 1) PG8_BAR;
        PG8_WAIT_V(2); PG8_BAR;
        PG8_STAGE(PG8_SB(1, 0), cB + kstep, voffB); PG8_STAGE(PG8_SA(1, 0), cA + kstep, voffA); PG8_STAGE(PG8_SB(1, 1), cB + hstep + kstep, voffB);
        PG8_WAIT_V(6); PG8_BAR;
    } else {
        PG8_STAGE(PG8_SB(0, 0), cB, voffB); PG8_STAGE(PG8_SA(0, 0), cA, voffA); PG8_STAGE(PG8_SB(0, 1), cB + hstep, voffB); PG8_STAGE(PG8_SA(0, 1), cA + hstep, voffA);
        if (wr == 1) PG8_BAR;
        PG8_WAIT_V(4); PG8_BAR;
        PG8_STAGE(PG8_SB(1, 0), cB + kstep, voffB); PG8_STAGE(PG8_SA(1, 0), cA + kstep, voffA); PG8_STAGE(PG8_SB(1, 1), cB + hstep + kstep, voffB);
        PG8_WAIT_V(6); PG8_BAR;
    }
    for (;;) {
        const bool has_next = S.next(ui + 1, nxt);
        const char* nA = has_next ? (const char*)g.A + (size_t)nxt.pm * tstep : cA; const char* nB = has_next ? (const char*)g.Bt + (size_t)nxt.pn * tstep : cB;
        for (int t = 0; t < nt; t += 2) {
            const bool last = (t == nt - 2);
            const char* a1 = cA + (size_t)(t + 1) * kstep;
            const char* a2 = last ? nA : cA + (size_t)(t + 2) * kstep; const char* b2 = last ? nB : cB + (size_t)(t + 2) * kstep;
            const char* a3 = a2 + kstep; const char* b3 = b2 + kstep;
            if (last && has_next) S.a_ready(nxt);
            if constexpr (SP2) {
            PG8_LDB(B0, 0, 0); PG8_LDB(B1, 0, 1); PG8_SCHED; PG8_LDA(At, 0, 0); PG8_STAGE(PG8_SA(1, 1), a1 + hstep, voffA);
            PG8_WAIT_V(8); PG8_WAIT_L(0); PG8_BAR; PG8_MMA(0, 0, At, B0); PG8_MMA(0, 1, At, B1); PG8_BAR; PG8_SCHED;
            PG8_LDA(At, 0, 1); PG8_STAGE(PG8_SB(0, 0), b2, voffB); PG8_STAGE(PG8_SB(0, 1), b2 + hstep, voffB); PG8_STAGE(PG8_SA(0, 0), a2, voffA);
            PG8_WAIT_V(8); PG8_WAIT_L(0); PG8_BAR; PG8_MMA(1, 0, At, B0); PG8_MMA(1, 1, At, B1); PG8_BAR; PG8_SCHED;
            PG8_LDB(B0, 1, 0); PG8_LDB(B1, 1, 1); PG8_SCHED; PG8_LDA(At, 1, 0); PG8_STAGE(PG8_SA(0, 1), a2 + hstep, voffA);
            PG8_WAIT_V(8); PG8_WAIT_L(0); PG8_BAR; PG8_MMA(0, 0, At, B0); PG8_MMA(0, 1, At, B1); PG8_BAR; PG8_SCHED;
            PG8_LDA(At, 1, 1); PG8_STAGE(PG8_SB(1, 0), b3, voffB); PG8_STAGE(PG8_SB(1, 1), b3 + hstep, voffB); PG8_STAGE(PG8_SA(1, 0), a3, voffA);
            PG8_WAIT_V(8); PG8_WAIT_L(0); PG8_BAR; PG8_MMA(1, 0, At, B0); PG8_MMA(1, 1, At, B1); PG8_BAR; PG8_SCHED;
            } else {
            PG8_LDB(B0, 0, 0); PG8_SCHED; PG8_LDA(At, 0, 0); PG8_STAGE(PG8_SA(1, 1), a1 + hstep, voffA);
            PG8_WAIT_L(8); PG8_BAR; PG8_WAIT_L(0); PG8_MMA(0, 0, At, B0); PG8_BAR; PG8_SCHED;
            PG8_LDB(B1, 0, 1); PG8_STAGE(PG8_SB(0, 0), b2, voffB);
            PG8_BAR; PG8_WAIT_L(0); PG8_MMA(0, 1, At, B1); PG8_BAR;
            PG8_LDA(At, 0, 1); PG8_STAGE(PG8_SA(0, 0), a2, voffA);
            PG8_BAR; PG8_WAIT_L(0); PG8_MMA(1, 0, At, B0); PG8_BAR; PG8_SCHED;
            PG8_STAGE(PG8_SB(0, 1), b2 + hstep, voffB);
            PG8_WAIT_V(6); PG8_BAR; PG8_MMA(1, 1, At, B1); PG8_BAR;
            PG8_LDB(B0, 1, 0); PG8_SCHED; PG8_LDA(At, 1, 0); PG8_STAGE(PG8_SA(0, 1), a2 + hstep, voffA);
            PG8_WAIT_L(8); PG8_BAR; PG8_WAIT_L(0); PG8_MMA(0, 0, At, B0); PG8_BAR; PG8_SCHED;
            PG8_LDB(B1, 1, 1); PG8_STAGE(PG8_SB(1, 0), b3, voffB);
            PG8_BAR; PG8_WAIT_L(0); PG8_MMA(0, 1, At, B1); PG8_BAR;
            PG8_LDA(At, 1, 1); PG8_STAGE(PG8_SA(1, 0), a3, voffA);
            PG8_BAR; PG8_WAIT_L(0); PG8_MMA(1, 0, At, B0); PG8_BAR; PG8_SCHED;
            PG8_STAGE(PG8_SB(1, 1), b3 + hstep, voffB);
            PG8_WAIT_V(6); PG8_BAR; PG8_MMA(1, 1, At, B1); PG8_BAR;
            }
        }
        if constexpr (ALIGN_EPI) { if (wr == 0) PG8_BAR; }
        if constexpr (!Epi::AFTER_DRAIN) { E(acc, cur, wr, wc, fr, fq); S.done(cur); }
        if (!has_next) break;
#pragma unroll
        for (int a = 0; a < 2; ++a)
#pragma unroll
            for (int b = 0; b < 2; ++b)
#pragma unroll
                for (int m = 0; m < 4; ++m)
#pragma unroll
                    for (int n = 0; n < 2; ++n) acc[a][b][m][n] = (f32x4){0.f, 0.f, 0.f, 0.f};
        cur = nxt; cA = nA; cB = nB; ++ui;
        if constexpr (ALIGN_EPI) { if (wr == 1) PG8_BAR; }
    }
    PG8_WAIT_V(0);
    if constexpr (!ALIGN_EPI) { if (wr == 0) PG8_BAR; }
    PG8_BAR;
    if constexpr (Epi::AFTER_DRAIN) { E.fused(acc, cur, wr, wc, fr, fq, lds, wid, lane); S.done(cur); }
#undef PG8_SA
#undef PG8_SB
#undef PG8_STAGE
#undef PG8_LDA
#undef PG8_LDB
#undef PG8_MMA
#undef PG8_WAIT_V
#undef PG8_WAIT_L
#undef PG8_BAR
#undef PG8_SCHED
}

}
#define LAS __attribute__((address_space(3)))
#define XB_TMO      128
#define XB_XCNT(j)  (256  + 64 * (j))
#define XB_XSUB(j)  (1280 + 64 * (j))
#define XB_XGEN(j)  (2304 + 64 * (j))
#define XB_TOP      3328
#define XB_TOPGEN   3392
#define XCD_BAR_WORDS 3456
#define XB_SPIN_CAP (1u << 18)
__device__ __forceinline__ unsigned xb_ld(unsigned* p)              { return __hip_atomic_load(p, __ATOMIC_RELAXED, __HIP_MEMORY_SCOPE_AGENT); }
__device__ __forceinline__ unsigned xb_add(unsigned* p, unsigned v) { return __hip_atomic_fetch_add(p, v, __ATOMIC_RELAXED, __HIP_MEMORY_SCOPE_AGENT); }
__device__ __forceinline__ unsigned xb_xcc_id() { return (unsigned)__builtin_amdgcn_s_getreg((3 << 11) | 20) & 0xFu; }
#define XB_SPIN(cond, bar) do { unsigned _sp = 0; while (cond) { __builtin_amdgcn_s_sleep(1); \
    if ((++_sp & 255u) == 0u) { if (xb_ld(&(bar)[XB_TMO])) break; if (_sp > XB_SPIN_CAP) { atomicAdd(&(bar)[XB_TMO], 1u); break; } } } } while (0)

struct XcdBarrier {
    unsigned* bar; unsigned x;
    volatile LAS unsigned* st;
};

__device__ __forceinline__ XcdBarrier xcd_barrier_post(unsigned* bar, volatile LAS unsigned* st) {
    XcdBarrier b; b.bar = bar; b.x = xb_xcc_id(); b.st = st;
    if (threadIdx.x == 0) (void)xb_add(&bar[XB_XCNT(b.x)], 1u);
    return b;
}
__device__ __forceinline__ void xcd_barrier_complete(unsigned* bar, unsigned x, unsigned& nloc, unsigned& nx) {
    const unsigned G = gridDim.x * gridDim.y * gridDim.z;
    unsigned sum, cnt, mine, sp = 0u;
    for (;;) {
        sum = 0u; cnt = 0u; mine = 0u;
#pragma unroll
        for (unsigned j = 0; j < 16; ++j) { const unsigned c = xb_ld(&bar[XB_XCNT(j)]); sum += c; cnt += (c > 0u) ? 1u : 0u; mine = (j == x) ? c : mine; }
        if (sum == G) break;
        __builtin_amdgcn_s_sleep(1);
        if ((++sp & 255u) == 0u) { if (xb_ld(&bar[XB_TMO])) break; if (sp > XB_SPIN_CAP) { atomicAdd(&bar[XB_TMO], 1u); break; } }
    }
    nloc = mine > 0u ? mine : 1u; nx = cnt > 0u ? cnt : 1u;
}

__device__ __forceinline__ void xcd_barrier(const XcdBarrier& b) {
    asm volatile("s_waitcnt vmcnt(0)" ::: "memory");
    __syncthreads();
    if (threadIdx.x == 0) {
        unsigned* bar = b.bar;
        __builtin_amdgcn_s_waitcnt(0);
        unsigned nloc = b.st[0], nx = b.st[1];
        if (nloc == 0u) { xcd_barrier_complete(bar, b.x, nloc, nx); b.st[0] = nloc; b.st[1] = nx; }
        const unsigned old = xb_add(&bar[XB_XSUB(b.x)], 1u);
        const unsigned gen = old / nloc;
        if (old + 1u == (gen + 1u) * nloc) {
            __builtin_amdgcn_fence(__ATOMIC_RELEASE, "agent");
            asm volatile("s_waitcnt vmcnt(0)" ::: "memory");
            const unsigned og = xb_add(&bar[XB_TOP], 1u);
            const unsigned tg = og / nx;
            if (og + 1u == (tg + 1u) * nx) xb_add(&bar[XB_TOPGEN], 1u);
            else XB_SPIN(xb_ld(&bar[XB_TOPGEN]) == tg, bar);
            __builtin_amdgcn_fence(__ATOMIC_ACQUIRE, "agent");
            xb_add(&bar[XB_XGEN(b.x)], 1u);
            asm volatile("s_waitcnt vmcnt(0)" ::: "memory");
        } else {
            XB_SPIN(xb_ld(&bar[XB_XGEN(b.x)]) == gen, bar);
            __builtin_amdgcn_fence(__ATOMIC_ACQUIRE, "agent");
            asm volatile("s_waitcnt vmcnt(0)" ::: "memory");
        }
    }
    __syncthreads();
}

using pg8::bf16_t; using pg8::bf16x8; using pg8::f32x4; using pg8::u32x4; typedef unsigned u32x2 __attribute__((ext_vector_type(2))); using pg8::Unit; using pg8::Gemm; using pg8::StaticOrder;
#define LAS3 __attribute__((address_space(3)))
DI int ltid() { int t = threadIdx.x; asm volatile("" : "+v"(t)); return t; }
#define LBAR() do { asm volatile("s_waitcnt lgkmcnt(0)" ::: "memory"); __builtin_amdgcn_s_barrier(); asm volatile("" ::: "memory"); } while (0)
#define MFMA16(a, b, c) __builtin_amdgcn_mfma_f32_16x16x32_bf16((a), (b), (c), 0, 0, 0)

struct Params { const float* in[23]; float* out; unsigned char* ws; int ph_lo, ph_hi; };

DI bf16_t* slotp(const Params& P, int s) { return (bf16_t*)(P.ws + WS_ACT + (size_t)s * USLOT); }
DI bf16_t* xrow16(const Params& P, int row) { return row < RL ? (bf16_t*)P.out + (size_t)row * 2048 : (bf16_t*)(P.ws + WS_CTX) + (size_t)(row - RL) * 2048; }

enum { M_H = 0, M_B = 1, M_GATES = 2, M_WA = 3, M_WB = 4, M_UP = 5, M_RES = 6 };
template <int MODE> struct Epi {
    static constexpr bool PERM = true, AFTER_DRAIN = false;
    bf16_t* o0; bf16_t* o1; bf16_t* o2; bf16_t* o3;
    const bf16_t* g0; const bf16_t* g1;
    float* xl; float* xc; const float* gate; float* dryp; const float* sl; const float* sc;
    __device__ __forceinline__ void operator()(const f32x4 (&acc)[2][2][4][2], const Unit& u, int wr, int wc, int fr, int fq) const {
        if constexpr (MODE == M_RES) {
            const int row0 = u.pm * 256 + wr * 64 + fr, colb = u.pn * 256 + wc * 32 + 8 * fq;
            const int mi = (u.pm * 256 < RL) ? ((u.pm * 256) >> 12) : 4; const float* gr = gate + mi * 6144 + colb;
            const f32x4 g00 = *(const f32x4*)gr, g01 = *(const f32x4*)(gr + 4), g10 = *(const f32x4*)(gr + 128), g11 = *(const f32x4*)(gr + 132);
#pragma unroll
            for (int ai = 0; ai < 2; ++ai)
#pragma unroll
                for (int mp = 0; mp < 2; ++mp) {
                    f32x4 xa[2][2][2]; bf16_t* xdp[2];
#pragma unroll
                    for (int mm = 0; mm < 2; ++mm) { const int row = row0 + ai * 128 + (2 * mp + mm) * 16;
                        bf16_t* xd = row < RL ? (bf16_t*)xl + (size_t)row * 2048 : (bf16_t*)xc + (size_t)(row - RL) * 2048; xdp[mm] = xd;
                        if (sl) { const float* xs = (row < RL ? sl + (size_t)row * 1024 : sc + (size_t)(row - RL) * 1024) + colb;
#pragma unroll
                            for (int bj = 0; bj < 2; ++bj) { xa[mm][bj][0] = *(const f32x4*)(xs + bj * 128); xa[mm][bj][1] = *(const f32x4*)(xs + bj * 128 + 4); } }
                        else {
#pragma unroll
                            for (int bj = 0; bj < 2; ++bj) { const u32x4 xw = *(const u32x4*)(xd + colb + bj * 128); xa[mm][bj][0] = (f32x4){bflo(xw.x), bfhi(xw.x), bflo(xw.y), bfhi(xw.y)}; xa[mm][bj][1] = (f32x4){bflo(xw.z), bfhi(xw.z), bflo(xw.w), bfhi(xw.w)}; } } }
#pragma unroll
                    for (int mm = 0; mm < 2; ++mm)
#pragma unroll
                        for (int bj = 0; bj < 2; ++bj) { const int m = 2 * mp + mm;
                            const f32x4 x0 = xa[mm][bj][0] + (bj ? g10 : g00) * acc[ai][bj][m][0], x1 = xa[mm][bj][1] + (bj ? g11 : g01) * acc[ai][bj][m][1];
                            u32x4 w; w.x = pk2(x0[0], x0[1]); w.y = pk2(x0[2], x0[3]); w.z = pk2(x1[0], x1[1]); w.w = pk2(x1[2], x1[3]); *(u32x4*)(xdp[mm] + colb + bj * 128) = w; }
                    asm volatile("" ::: "memory");
                }
        } else {
            const int row0 = u.pm * 256 + wr * 64 + fr;
            int part = 0, colt = u.pn * 256, ld = 1024; bf16_t* ob = o0;
            if constexpr (MODE == M_H || MODE == M_B || MODE == M_GATES) { part = u.pn >> 2; colt = (u.pn & 3) * 256; ob = part == 0 ? o0 : (part == 1 ? o1 : (part == 2 ? o2 : o3)); }
            if constexpr (MODE == M_UP) { ld = DFF; if (u.pn >= 11) { ob = o1; colt = (u.pn - 11) * 256; } }
#pragma unroll
            for (int ai = 0; ai < 2; ++ai)
#pragma unroll
                for (int m = 0; m < 4; ++m) {
                    const int row = row0 + ai * 128 + m * 16; float st1 = 0.f, st2 = 0.f;
#pragma unroll
                    for (int bj = 0; bj < 2; ++bj) {
                        const int col = colt + bj * 128 + wc * 32 + 8 * fq; const size_t off = (size_t)row * ld + col;
                        float v[8]; { const f32x4 a = acc[ai][bj][m][0], b = acc[ai][bj][m][1]; v[0] = a[0]; v[1] = a[1]; v[2] = a[2]; v[3] = a[3]; v[4] = b[0]; v[5] = b[1]; v[6] = b[2]; v[7] = b[3]; }
                        u32x4 w;
                        if constexpr (MODE == M_H) {
                            if (part == 1 || part == 2) { const float* lbp = gate + (part - 1) * 1024 + col; const f32x4 l0 = *(const f32x4*)lbp, l1 = *(const f32x4*)(lbp + 4); const float lbv[8] = {l0[0], l0[1], l0[2], l0[3], l1[0], l1[1], l1[2], l1[3]};
#pragma unroll
                                for (int j = 0; j < 8; ++j) v[j] = fmaxf(__builtin_amdgcn_logf(lbv[j] + (1.0f - lbv[j]) * sigm(v[j])), -43.0f);
                                w.x = pkh2(v[0], v[1]); w.y = pkh2(v[2], v[3]); w.z = pkh2(v[4], v[5]); w.w = pkh2(v[6], v[7]); }
                            else { if (part == 0) {
#pragma unroll
                                    for (int j = 0; j < 8; ++j) v[j] = silu_f(v[j]); }
                                w.x = pk2(v[0], v[1]); w.y = pk2(v[2], v[3]); w.z = pk2(v[4], v[5]); w.w = pk2(v[6], v[7]); }
                        } else {
                            if constexpr (MODE == M_B) {
                                if (part >= 3) { unsigned q[8];
#pragma unroll
                                    for (int j = 0; j < 8; ++j) q[j] = (unsigned)(sigm(v[j]) * 255.0f + 0.5f);
                                    u32x2 wb; wb.x = q[0] | (q[1] << 8) | (q[2] << 16) | (q[3] << 24); wb.y = q[4] | (q[5] << 8) | (q[6] << 16) | (q[7] << 24);
                                    *(u32x2*)((unsigned char*)o3 + (size_t)row * 2048 + (part - 3) * 1024 + col) = wb; continue; }
                                if (part == 2) {
#pragma unroll
                                    for (int j = 0; j < 8; ++j) v[j] = silu_f(v[j]); }
                                else {
#pragma unroll
                                    for (int j = 0; j < 8; ++j) v[j] = gelu_t(v[j]);
                                    if (part == 1) { float s1 = 0.f, s2 = 0.f;
#pragma unroll
                                        for (int j = 0; j < 8; ++j) { s1 += v[j]; s2 += v[j] * v[j]; }
                                        st1 += s1; st2 += s2; } } }
                            if constexpr (MODE == M_GATES) {
#pragma unroll
                                for (int j = 0; j < 8; ++j) v[j] = sigm(v[j]); }
                            if constexpr (MODE == M_WA || MODE == M_WB) {
                                const u32x2 gw = *(const u32x2*)((const unsigned char*)g0 + (size_t)row * 2048 + col);
                                constexpr float I255 = 1.0f / 255.0f;
                                v[0] *= (float)(gw.x & 255u) * I255; v[1] *= (float)((gw.x >> 8) & 255u) * I255; v[2] *= (float)((gw.x >> 16) & 255u) * I255; v[3] *= (float)(gw.x >> 24) * I255;
                                v[4] *= (float)(gw.y & 255u) * I255; v[5] *= (float)((gw.y >> 8) & 255u) * I255; v[6] *= (float)((gw.y >> 16) & 255u) * I255; v[7] *= (float)(gw.y >> 24) * I255; }
                            if constexpr (MODE == M_WB) {
                                const u32x4 tw = *(const u32x4*)(g1 + off);
                                v[0] += bflo(tw.x); v[1] += bfhi(tw.x); v[2] += bflo(tw.y); v[3] += bfhi(tw.y); v[4] += bflo(tw.z); v[5] += bfhi(tw.z); v[6] += bflo(tw.w); v[7] += bfhi(tw.w); }
                            w.x = pk2(v[0], v[1]); w.y = pk2(v[2], v[3]); w.z = pk2(v[4], v[5]); w.w = pk2(v[6], v[7]);
                        }
                        *(u32x4*)(ob + off) = w;
                    }
                    if constexpr (MODE == M_B) { if (part == 1) { st1 += __shfl_xor(st1, 16); st1 += __shfl_xor(st1, 32); st2 += __shfl_xor(st2, 16); st2 += __shfl_xor(st2, 32);
                            if (fq == 0) { float* sp = (float*)gate + ((size_t)row * 16 + (u.pn & 3) * 4 + wc) * 2; *(float2*)sp = make_float2(st1, st2); } } }
                    if (!(MODE == M_WA || MODE == M_WB) || (m & 1)) asm volatile("" ::: "memory");
                }
        }
    }
};

template <int MODE> DI void run_gemm(unsigned char* lds, const bf16_t* A, const bf16_t* Bt, int M, int N, int K, const Epi<MODE>& E) {
    Gemm g{A, Bt, M, N, K}; StaticOrder S; S.init(M, N, (int)gridDim.x, (int)blockIdx.x);
    pg8::gemm_phase<Epi<MODE>, StaticOrder, true, true>((LAS3 unsigned char*)lds, g, S, E);
}

DI void ctx_res_gemm(const Params& P, unsigned char* lds, const bf16_t* A, int lda, const bf16_t* Bt, int K, const float* gate, const float* xsrc_f32) {
    const int tid = ltid(), lane = tid & 63, wid = tid >> 6, fr = lane & 15, fq = lane >> 4;
    unsigned short* LA = (unsigned short*)lds; unsigned short* LB = LA + 64 * 264;
    for (int tile = blockIdx.x; tile < 256; tile += gridDim.x) {
        const int tm = tile >> 4, tn = tile & 15;
        const bf16_t* ag = A + (size_t)(tm * 64) * lda; const bf16_t* bg = Bt + (size_t)(tn * 64) * K;
        uint4 ra0, ra1, ra2, ra3, rb0, rb1, rb2, rb3;
        const int pr_ = tid >> 5, pc_ = (tid & 31) * 8;
#define CTX_FETCH(k0) do { const bf16_t* a_ = ag + (size_t)pr_ * lda + (k0) + pc_; const bf16_t* b_ = bg + (size_t)pr_ * K + (k0) + pc_; \
            ra0 = *(const uint4*)a_; ra1 = *(const uint4*)(a_ + (size_t)16 * lda); ra2 = *(const uint4*)(a_ + (size_t)32 * lda); ra3 = *(const uint4*)(a_ + (size_t)48 * lda); \
            rb0 = *(const uint4*)b_; rb1 = *(const uint4*)(b_ + (size_t)16 * K); rb2 = *(const uint4*)(b_ + (size_t)32 * K); rb3 = *(const uint4*)(b_ + (size_t)48 * K); } while (0)
        CTX_FETCH(0);
        f32x4 acc0 = (f32x4){0.f, 0.f, 0.f, 0.f}, acc1 = acc0;
        for (int k = 0; k < K; k += 256) {
            __syncthreads();
            { unsigned short* la_ = LA + pr_ * 264 + pc_; unsigned short* lb_ = LB + pr_ * 264 + pc_;
                *(uint4*)la_ = ra0; *(uint4*)(la_ + 16 * 264) = ra1; *(uint4*)(la_ + 32 * 264) = ra2; *(uint4*)(la_ + 48 * 264) = ra3;
                *(uint4*)lb_ = rb0; *(uint4*)(lb_ + 16 * 264) = rb1; *(uint4*)(lb_ + 32 * 264) = rb2; *(uint4*)(lb_ + 48 * 264) = rb3; }
            __syncthreads();
            if (k + 256 < K) CTX_FETCH(k + 256);
            bf16x8 a[8], b0[8], b1[8];
#pragma unroll
            for (int j = 0; j < 8; ++j) { a[j] = *(const bf16x8*)(LA + (16 * (wid & 3) + fr) * 264 + 32 * j + 8 * fq); b0[j] = *(const bf16x8*)(LB + (32 * (wid >> 2) + fr) * 264 + 32 * j + 8 * fq); b1[j] = *(const bf16x8*)(LB + (32 * (wid >> 2) + 16 + fr) * 264 + 32 * j + 8 * fq); }
#pragma unroll
            for (int j = 0; j < 8; ++j) { acc0 = MFMA16(b0[j], a[j], acc0); acc1 = MFMA16(b1[j], a[j], acc1); }
        }
#undef CTX_FETCH
        const int row = tm * 64 + 16 * (wid & 3) + fr, c0 = tn * 64 + 32 * (wid >> 2); bf16_t* xd = (bf16_t*)(P.ws + WS_CTX) + (size_t)row * 2048;
#pragma unroll
        for (int e = 0; e < 2; ++e) { const int col = c0 + 16 * e + 4 * fq; const f32x4 acc = e ? acc1 : acc0; const f32x4 gv = *(const f32x4*)(gate + col); f32x4 xv;
            if (xsrc_f32) xv = *(const f32x4*)(xsrc_f32 + (size_t)row * 1024 + col);
            else { const uint2 xw = *(const uint2*)(xd + col); xv = (f32x4){bflo(xw.x), bfhi(xw.x), bflo(xw.y), bfhi(xw.y)}; }
            xv = xv + gv * acc; uint2 w; w.x = pk2(xv[0], xv[1]); w.y = pk2(xv[2], xv[3]); *(uint2*)(xd + col) = w; }
    }
}

DI void ctx_ab_gemm(const Params& P, unsigned char* lds) {
    const int tid = ltid(), lane = tid & 63, wid = tid >> 6, fr = lane & 15, fq = lane >> 4;
    unsigned short* LA = (unsigned short*)lds; unsigned short* LB = LA + 64 * 264;
    const bf16_t* ya = slotp(P, 3) + (size_t)RL * 1024; const bf16_t* yb = slotp(P, 1) + (size_t)RL * 1024;
    const bf16_t* Wa = (const bf16_t*)(P.ws + WS_WA); const bf16_t* Wb = (const bf16_t*)(P.ws + WS_WB);
    const int pr_ = tid >> 5, pc_ = (tid & 31) * 8;
    for (int tile = blockIdx.x; tile < 256; tile += gridDim.x) {
        const int tm = tile >> 4, tn = tile & 15;
        uint4 ra0, ra1, ra2, ra3, rb0, rb1, rb2, rb3;
#define AB_FETCH(si) do { const bf16_t* a_ = (((si) >> 2) ? yb : ya) + (size_t)(tm * 64 + pr_) * 1024 + ((si) & 3) * 256 + pc_; const bf16_t* b_ = (((si) >> 2) ? Wb : Wa) + (size_t)(tn * 64 + pr_) * 1024 + ((si) & 3) * 256 + pc_; \
            ra0 = *(const uint4*)a_; ra1 = *(const uint4*)(a_ + 16 * 1024); ra2 = *(const uint4*)(a_ + 32 * 1024); ra3 = *(const uint4*)(a_ + 48 * 1024); \
            rb0 = *(const uint4*)b_; rb1 = *(const uint4*)(b_ + 16 * 1024); rb2 = *(const uint4*)(b_ + 32 * 1024); rb3 = *(const uint4*)(b_ + 48 * 1024); } while (0)
        AB_FETCH(0);
        f32x4 acc[2][2];
        acc[0][0] = (f32x4){0.f, 0.f, 0.f, 0.f}; acc[0][1] = acc[0][0]; acc[1][0] = acc[0][0]; acc[1][1] = acc[0][0];
#pragma unroll
        for (int si = 0; si < 8; ++si) {
            __syncthreads();
            { unsigned short* la_ = LA + pr_ * 264 + pc_; unsigned short* lb_ = LB + pr_ * 264 + pc_;
                *(uint4*)la_ = ra0; *(uint4*)(la_ + 16 * 264) = ra1; *(uint4*)(la_ + 32 * 264) = ra2; *(uint4*)(la_ + 48 * 264) = ra3;
                *(uint4*)lb_ = rb0; *(uint4*)(lb_ + 16 * 264) = rb1; *(uint4*)(lb_ + 32 * 264) = rb2; *(uint4*)(lb_ + 48 * 264) = rb3; }
            __syncthreads();
            if (si + 1 < 8) AB_FETCH(si + 1);
            bf16x8 a[8], b0[8], b1[8];
#pragma unroll
            for (int j = 0; j < 8; ++j) { a[j] = *(const bf16x8*)(LA + (16 * (wid & 3) + fr) * 264 + 32 * j + 8 * fq); b0[j] = *(const bf16x8*)(LB + (32 * (wid >> 2) + fr) * 264 + 32 * j + 8 * fq); b1[j] = *(const bf16x8*)(LB + (32 * (wid >> 2) + 16 + fr) * 264 + 32 * j + 8 * fq); }
#pragma unroll
            for (int j = 0; j < 8; ++j) { acc[si >> 2][0] = MFMA16(b0[j], a[j], acc[si >> 2][0]); acc[si >> 2][1] = MFMA16(b1[j], a[j], acc[si >> 2][1]); }
        }
#undef AB_FETCH
        const int grow = RL + tm * 64 + 16 * (wid & 3) + fr, c0 = tn * 64 + 32 * (wid >> 2);
        const unsigned char* gp = (const unsigned char*)slotp(P, 6) + (size_t)grow * 2048; bf16_t* md = slotp(P, 2) + (size_t)grow * 1024; constexpr float I255 = 1.0f / 255.0f;
#pragma unroll
        for (int e = 0; e < 2; ++e) { const int col = c0 + 16 * e + 4 * fq; const unsigned ga = *(const unsigned*)(gp + col), gb = *(const unsigned*)(gp + 1024 + col);
            const f32x4 A = acc[0][e], B = acc[1][e]; float m[4];
#pragma unroll
            for (int i = 0; i < 4; ++i) m[i] = (float)((ga >> (8 * i)) & 255u) * I255 * A[i] + (float)((gb >> (8 * i)) & 255u) * I255 * B[i];
            uint2 w; w.x = pk2(m[0], m[1]); w.y = pk2(m[2], m[3]); *(uint2*)(md + col) = w; }
    }
}

struct ConvItem { const float* src; bf16_t* dst; int K, N, tile; };
constexpr int CV_IN = 16 * 144, CV_SQ = 256, CV_UP = 16 * 88, CV_DN = 44 * 16, CV_WS = 32;
constexpr int CV_E0 = CV_IN, CV_E1 = CV_E0 + CV_SQ, CV_E2 = CV_E1 + CV_SQ, CV_E3 = CV_E2 + CV_SQ, CV_E4 = CV_E3 + CV_UP, CV_E5 = CV_E4 + CV_DN, CV_E6 = CV_E5 + CV_WS;
DI bool conv_item(const Params& P, int l, int it, int sel, ConvItem& c) {
    if (it >= CV_E5) return false;
    const bool is_dn = (it >= CV_E4), is_in = it < CV_E0; if ((sel == 1 && is_dn) || (sel == 2 && !is_dn) || (sel == 3 && !is_in) || (sel == 4 && is_in)) return false;
    if (it < CV_E0) { c.src = P.in[7] + (size_t)l * 1024 * DIN; c.dst = (bf16_t*)(P.ws + WS_WIN); c.K = 1024; c.N = DIN; c.tile = it; }
    else if (it < CV_E1) { c.src = P.in[14] + (size_t)l * 1024 * 1024; c.dst = (bf16_t*)(P.ws + WS_WA); c.K = 1024; c.N = 1024; c.tile = it - CV_E0; }
    else if (it < CV_E2) { c.src = P.in[15] + (size_t)l * 1024 * 1024; c.dst = (bf16_t*)(P.ws + WS_WB); c.K = 1024; c.N = 1024; c.tile = it - CV_E1; }
    else if (it < CV_E3) { c.src = P.in[16] + (size_t)l * 1024 * 1024; c.dst = (bf16_t*)(P.ws + WS_WO); c.K = 1024; c.N = 1024; c.tile = it - CV_E2; }
    else if (it < CV_E4) { c.src = P.in[18] + (size_t)l * 1024 * 2 * DFF; c.dst = (bf16_t*)(P.ws + WS_WUP); c.K = 1024; c.N = 2 * DFF; c.tile = it - CV_E3; }
    else { c.src = P.in[21] + (size_t)l * DFF * 1024; c.dst = (bf16_t*)(P.ws + WS_WDN); c.K = DFF; c.N = 1024; c.tile = it - CV_E4; }
    return true;
}
DI void convert_weights(const Params& P, int l, unsigned char* lds, int sel = 0, int first_wg = 0) {
    unsigned short* T = (unsigned short*)lds;
    if ((int)blockIdx.x < first_wg) return;
    const int tid = ltid(), step = (int)gridDim.x - first_wg, kr = tid >> 4, nc = (tid & 15) * 4;
    int it = (int)blockIdx.x - first_wg; ConvItem cur{}, nxt{}; bool hc = false;
    while (it < CV_E5 && !(hc = conv_item(P, l, it, sel, cur))) it += step;
    float4 v0 = make_float4(0.f, 0.f, 0.f, 0.f), v1 = v0;
#define CV_FETCH(ci) do { const int ntn_ = (ci).N >> 6, tk_ = (ci).tile / ntn_, tn_ = (ci).tile - tk_ * ntn_; const float* s_ = (ci).src + (size_t)(tk_ * 64 + kr) * (ci).N + tn_ * 64 + nc; v0 = *(const float4*)s_; v1 = *(const float4*)(s_ + (size_t)32 * (ci).N); } while (0)
    if (hc) CV_FETCH(cur);
    while (hc) {
        int itn = it + step; bool hn = false;
        while (itn < CV_E5 && !(hn = conv_item(P, l, itn, sel, nxt))) itn += step;
        T[(nc + 0) * 72 + kr] = f2bf(v0.x); T[(nc + 1) * 72 + kr] = f2bf(v0.y); T[(nc + 2) * 72 + kr] = f2bf(v0.z); T[(nc + 3) * 72 + kr] = f2bf(v0.w);
        T[(nc + 0) * 72 + kr + 32] = f2bf(v1.x); T[(nc + 1) * 72 + kr + 32] = f2bf(v1.y); T[(nc + 2) * 72 + kr + 32] = f2bf(v1.z); T[(nc + 3) * 72 + kr + 32] = f2bf(v1.w);
        __syncthreads();
        if (hn) CV_FETCH(nxt);
        { const int ntn = cur.N >> 6, tk = cur.tile / ntn, tn = cur.tile - tk * ntn, n = tid >> 3, kc = (tid & 7) * 8; const uint4 w = *(const uint4*)(T + n * 72 + kc); *(uint4*)(cur.dst + (size_t)(tn * 64 + n) * cur.K + tk * 64 + kc) = w; }
        __syncthreads();
        cur = nxt; it = itn; hc = hn;
    }
#undef CV_FETCH
    if (sel == 0 || sel == 4 || sel == 1) for (int t = (int)blockIdx.x - first_wg; t < CV_WS; t += step) { const float* sp = P.in[10] + (size_t)l * 8 * 128 * 128 + t * 4096; bf16_t* d = (bf16_t*)(P.ws + WS_WS) + t * 4096;
        for (int i = tid; i < 4096; i += 512) d[i] = f2bf(sp[i]); }
}

DI void phase_prologue(const Params& P, unsigned char* lds) {
    const int tid = ltid(), bid = blockIdx.x, G = gridDim.x;
    float* sl = (float*)lds; float* red = sl + 5 * 1024; float* modt = (float*)(P.ws + WS_MOD);
    bool have = false;
    for (int it = bid; it < 96; it += G) {
        if (!have) { for (int i = tid; i < 5 * 1024; i += 512) { const int m = i >> 10, k = i & 1023; const float c = m < 4 ? P.in[1][m * 1024 + k] : P.in[3][k]; sl[i] = c / (1.0f + expf(-c)); } __syncthreads(); have = true; }
        const int l = it / 48, cb = it - l * 48, col = cb * 128 + (tid & 127), kq = tid >> 7;
        const float* W = P.in[4] + (size_t)l * 1024 * 6144 + col;
        float a0 = 0.f, a1 = 0.f, a2 = 0.f, a3 = 0.f, a4 = 0.f;
#pragma unroll 16
        for (int k = kq * 256; k < kq * 256 + 256; ++k) { const float w = W[(size_t)k * 6144]; a0 += sl[k] * w; a1 += sl[1024 + k] * w; a2 += sl[2048 + k] * w; a3 += sl[3072 + k] * w; a4 += sl[4096 + k] * w; }
        float* rr = red + (kq * 5) * 128 + (tid & 127); rr[0] = a0; rr[128] = a1; rr[256] = a2; rr[384] = a3; rr[512] = a4;
        __syncthreads();
        if (tid < 128) { const float bias = P.in[5][l * 6144 + col];
#pragma unroll
            for (int m = 0; m < 5; ++m) modt[(l * 5 + m) * 6144 + col] = red[(0 * 5 + m) * 128 + tid] + red[(1 * 5 + m) * 128 + tid] + red[(2 * 5 + m) * 128 + tid] + red[(3 * 5 + m) * 128 + tid] + bias; }
        __syncthreads();
    }
    if (bid == G - 1) { float* lbt = (float*)(P.ws + WS_LB); for (int i = tid; i < 2048; i += 512) { const float h0 = P.in[12][i], h1 = P.in[12][2048 + i]; lbt[i] = 0.f; lbt[2048 + i] = 1.0f / (1.0f + expf(h0 - h1)); } }
    __syncthreads();
    convert_weights(P, 0, lds, 3, 96);
}

DI void norm_phase(const Params& P, int l, int which, bf16_t* dst, int nrows) {
    const bool from_in = (l == 0 && which == 0);
    const int tid_ = ltid(); const int lane = tid_ & 63, wid = tid_ >> 6;
    const float* nw = (which ? P.in[17] : P.in[6]) + l * 1024; const float* modt = (const float*)(P.ws + WS_MOD) + (size_t)l * 5 * 6144 + (which ? 3 : 0) * 1024;
    const int nw_tot = gridDim.x * 8;
    for (int rowb = blockIdx.x * 8 + wid; rowb < nrows; rowb += 2 * nw_tot) {
        float4 v[2][4]; int rows[2] = {rowb, rowb + nw_tot};
#pragma unroll
        for (int r = 0; r < 2; ++r) { const int row = rows[r] < nrows ? rows[r] : rowb;
            if (from_in) { const float4* xr = (const float4*)(row < RL ? P.in[0] + (size_t)row * 1024 : P.in[2] + (size_t)(row - RL) * 1024);
#pragma unroll
                for (int q = 0; q < 4; ++q) v[r][q] = xr[q * 64 + lane]; }
            else { const uint2* xr = (const uint2*)xrow16(P, row);
#pragma unroll
                for (int q = 0; q < 4; ++q) { const uint2 w = xr[q * 64 + lane]; v[r][q] = make_float4(bflo(w.x), bfhi(w.x), bflo(w.y), bfhi(w.y)); } } }
#pragma unroll
        for (int r = 0; r < 2; ++r) { const int row = rows[r]; if (row >= nrows) continue; float ss = 0.f;
#pragma unroll
            for (int q = 0; q < 4; ++q) ss += v[r][q].x * v[r][q].x + v[r][q].y * v[r][q].y + v[r][q].z * v[r][q].z + v[r][q].w * v[r][q].w;
            ss = wave_sum(ss); const float rstd = __builtin_amdgcn_rsqf(ss * (1.0f / 1024.0f) + 1e-6f);
            const int mi = row < RL ? (row >> 12) : 4; const float* sh = modt + mi * 6144; const float* sc = sh + 1024;
#pragma unroll
            for (int q = 0; q < 4; ++q) { const int col = 4 * (q * 64 + lane); const float4 w = *(const float4*)(nw + col), s = *(const float4*)(sc + col), h = *(const float4*)(sh + col);
                uint2 o; o.x = pk2(v[r][q].x * rstd * w.x * (1.f + s.x) + h.x, v[r][q].y * rstd * w.y * (1.f + s.y) + h.y); o.y = pk2(v[r][q].z * rstd * w.z * (1.f + s.z) + h.z, v[r][q].w * rstd * w.w * (1.f + s.w) + h.w);
                *(uint2*)(dst + (size_t)row * 1024 + col) = o; } }
    }
}

DI int scan_row0(int c, int b, int dir) { if (c < 4) { const int m = dir ? 3 - c : c; return RL + b * 256 + 64 * m; } const int n = c - 4, nn = dir ? 63 - n : n; return b * 4096 + 64 * nn; }
DI void scanprep_phase(const Params& P, unsigned char* lds, int l) {
    const int tid = ltid(), lane = tid & 63, to = tid >> 6, k0 = 2 * lane;
    float* tot = (float*)lds;
    const unsigned short* qh = slotp(P, 1); float* vec = (float*)(P.ws + WS_VEC);
    unsigned gr[8], qr[8];
#define PREP_LOAD(it) do { const int ch_ = (it) >> 4, hd_ = ((it) >> 1) & 7, dr_ = (it) & 1; unsigned vb_ = (unsigned)((ch_ * 64 + (dr_ ? 63 - 8 * to : 8 * to)) * 1024 + hd_ * 128 + k0); asm volatile("" : "+v"(vb_)); \
        const unsigned short* gb_ = slotp(P, dr_ ? 3 : 2); const int st_ = dr_ ? -1024 : 1024; \
        _Pragma("unroll") for (int j = 0; j < 8; ++j) { const unsigned o_ = vb_ + (unsigned)(j * st_); gr[j] = *(const unsigned*)(gb_ + o_); qr[j] = *(const unsigned*)(qh + o_); } } while (0)
    int item = blockIdx.x;
    if (item < 272 * 16) PREP_LOAD(item);
    for (; item < 272 * 16; item += gridDim.x) {
        const int chunk = item >> 4, hd = (item >> 1) & 7, dir = item & 1;
        float g0[8], g1[8]; float run0 = 0.f, run1 = 0.f; unsigned qc[8];
#pragma unroll
        for (int j = 0; j < 8; ++j) { g0[j] = h2f((unsigned short)(gr[j] & 0xffffu)); g1[j] = h2f((unsigned short)(gr[j] >> 16)); run0 += g0[j]; run1 += g1[j]; qc[j] = qr[j]; }
        if (item + (int)gridDim.x < 272 * 16) PREP_LOAD(item + (int)gridDim.x);
        *(float2*)(tot + to * 128 + k0) = make_float2(run0, run1);
        LBAR();
        float off0 = 0.f, off1 = 0.f, ref0 = 0.f, ref1 = 0.f, a0 = 0.f, a1 = 0.f;
#pragma unroll
        for (int o = 0; o < 8; ++o) { const float2 t = *(const float2*)(tot + o * 128 + k0); if (o == to) { off0 = a0; off1 = a1; } a0 += t.x; a1 += t.y; if (o == 3) { ref0 = a0; ref1 = a1; } }
        float bb0 = off0, bb1 = off1; unsigned qo[8], ko[8];
#pragma unroll
        for (int j = 0; j < 8; ++j) { bb0 += g0[j]; bb1 += g1[j];
            const float kk0 = 1.0f - __builtin_amdgcn_exp2f(g0[j]), kk1 = 1.0f - __builtin_amdgcn_exp2f(g1[j]);
            const float E0 = __builtin_amdgcn_exp2f(bb0 - ref0), E1 = __builtin_amdgcn_exp2f(bb1 - ref1), R0 = __builtin_amdgcn_rcpf(E0), R1 = __builtin_amdgcn_rcpf(E1);
            qo[j] = pk2(bflo(qc[j]) * E0, bfhi(qc[j]) * E1); ko[j] = pk2(kk0 * R0, kk1 * R1); }
        { unsigned vb_ = (unsigned)((chunk * 64 + (dir ? 63 - 8 * to : 8 * to)) * 1024 + hd * 128 + k0); asm volatile("" : "+v"(vb_));
            unsigned short* qb_ = slotp(P, dir ? 3 : 2); unsigned short* kb_ = slotp(P, 5 + dir); const int st_ = dir ? -1024 : 1024;
#pragma unroll
            for (int j = 0; j < 8; ++j) { const unsigned o_ = vb_ + (unsigned)(j * st_); *(unsigned*)(qb_ + o_) = qo[j]; *(unsigned*)(kb_ + o_) = ko[j]; } }
        if (to == 0) { float* vc = vec + (size_t)((chunk * 8 + hd) * 2 + dir) * 256; *(float2*)(vc + k0) = make_float2(__builtin_amdgcn_exp2f(ref0), __builtin_amdgcn_exp2f(ref1)); *(float2*)(vc + 128 + k0) = make_float2(__builtin_amdgcn_exp2f(a0 - ref0), __builtin_amdgcn_exp2f(a1 - ref1)); }
        LBAR();
    }
#undef PREP_LOAD
}
DI void scan_phase(const Params& P, unsigned char* lds, int l) {
    const int tid = ltid(), lane = tid & 63, wid = tid >> 6, fr = lane & 15, fq = lane >> 4;
    const int bid = blockIdx.x; if (bid >= 256) return;
    const int vq = bid >> 6, b = (bid >> 4) & 3, hd = (bid >> 1) & 7, dir = bid & 1;
    unsigned short* Qt = (unsigned short*)lds; unsigned short* Kt = Qt + 64 * 136; unsigned short* KtT = Kt + 64 * 136;
    unsigned short* VT = KtT + 128 * 72; unsigned short* Pm = VT + 32 * 72; unsigned short* ST = Pm + 64 * 72;
    const unsigned short* qi = slotp(P, dir ? 3 : 2); const unsigned short* kb = slotp(P, 5 + dir); const unsigned short* iv = slotp(P, 4); const float* vec = (const float*)(P.ws + WS_VEC);
    const unsigned opitch = dir ? 2048u : 1024u;
    const int to = wid, k0 = 2 * lane, cidx = hd * 128 + k0; const bool vmine = (lane >> 4) == vq;
    for (int i = tid; i < 32 * 136 / 2; i += 512) ((unsigned*)ST)[i] = 0u;
    f32x4 S[2];
    S[0] = (f32x4){0.f, 0.f, 0.f, 0.f}; S[1] = (f32x4){0.f, 0.f, 0.f, 0.f};
    unsigned qa_[8], ka_[8], va_[8], qb_r[8], kb_r[8], vb_r[8]; f32x4 era, ela, erb, elb;
    const unsigned vbase = (unsigned)((dir ? 63 - 8 * to : 8 * to) * 1024 + cidx); const int vstep = dir ? -1024 : 1024;
#define SCAN_LOAD(rb, Q_, K_, V_, E_, L_) do { unsigned vb_ = vbase; asm volatile("" : "+v"(vb_)); const unsigned short* qb_ = qi + (size_t)(rb) * 1024; const unsigned short* kb_ = kb + (size_t)(rb) * 1024; const unsigned short* ib_ = iv + (size_t)(rb) * 1024; \
        _Pragma("unroll") for (int j = 0; j < 8; ++j) { const unsigned o_ = vb_ + (unsigned)(j * vstep); Q_[j] = *(const unsigned*)(qb_ + o_); K_[j] = *(const unsigned*)(kb_ + o_); if (vmine) V_[j] = *(const unsigned*)(ib_ + o_); } \
        const float* vc_ = vec + (size_t)(((rb) >> 6) * 8 + hd) * 2 * 256 + dir * 256 + 16 * wid + 4 * fq; E_ = *(const f32x4*)vc_; L_ = *(const f32x4*)(vc_ + 128); } while (0)
#define SCAN_ITER(CC, QR, KR, VR, ER, EL, ERN) do { \
        const int row0 = scan_row0(CC, b, dir); const f32x4 erc = ER, elc = EL; \
        _Pragma("unroll") for (int j = 0; j < 8; ++j) { const int tau = 8 * to + j; *(unsigned*)(Qt + tau * 136 + k0) = QR[j]; *(unsigned*)(Kt + tau * 136 + k0) = KR[j]; } \
        { uint4 w; w.x = (KR[0] & 0xffffu) | (KR[1] << 16); w.y = (KR[2] & 0xffffu) | (KR[3] << 16); w.z = (KR[4] & 0xffffu) | (KR[5] << 16); w.w = (KR[6] & 0xffffu) | (KR[7] << 16); *(uint4*)(KtT + k0 * 72 + 8 * to) = w; \
            w.x = (KR[0] >> 16) | (KR[1] & 0xffff0000u); w.y = (KR[2] >> 16) | (KR[3] & 0xffff0000u); w.z = (KR[4] >> 16) | (KR[5] & 0xffff0000u); w.w = (KR[6] >> 16) | (KR[7] & 0xffff0000u); *(uint4*)(KtT + (k0 + 1) * 72 + 8 * to) = w; } \
        if (vmine) { const int vl = k0 & 31; uint4 w; w.x = (VR[0] & 0xffffu) | (VR[1] << 16); w.y = (VR[2] & 0xffffu) | (VR[3] << 16); w.z = (VR[4] & 0xffffu) | (VR[5] << 16); w.w = (VR[6] & 0xffffu) | (VR[7] << 16); *(uint4*)(VT + vl * 72 + 8 * to) = w; \
            w.x = (VR[0] >> 16) | (VR[1] & 0xffff0000u); w.y = (VR[2] >> 16) | (VR[3] & 0xffff0000u); w.z = (VR[4] >> 16) | (VR[5] & 0xffff0000u); w.w = (VR[6] >> 16) | (VR[7] & 0xffff0000u); *(uint4*)(VT + (vl + 1) * 72 + 8 * to) = w; } \
        if ((CC) + 2 < 68) { SCAN_LOAD(scan_row0((CC) + 2, b, dir), QR, KR, VR, ER, EL); } \
        LBAR(); \
        const bool live_ = !(l == 1 && (CC) < 4);                                    \
        if (live_) { const int ti = wid >> 1; \
            _Pragma("unroll") for (int e = 0; e < 2; ++e) { const int si = 2 * (wid & 1) + e; f32x4 acc = (f32x4){0.f, 0.f, 0.f, 0.f}; \
                if (si <= ti) { \
                    _Pragma("unroll") for (int ks = 0; ks < 4; ++ks) { const bf16x8 a = *(const bf16x8*)(Qt + (16 * ti + fr) * 136 + 32 * ks + 8 * fq); const bf16x8 bq = *(const bf16x8*)(Kt + (16 * si + fr) * 136 + 32 * ks + 8 * fq); acc = MFMA16(bq, a, acc); } } \
                const int t = 16 * ti + fr, s0 = 16 * si + 4 * fq; uint2 w; w.x = pk2(s0 <= t ? acc[0] : 0.f, s0 + 1 <= t ? acc[1] : 0.f); w.y = pk2(s0 + 2 <= t ? acc[2] : 0.f, s0 + 3 <= t ? acc[3] : 0.f); \
                *(uint2*)(Pm + t * 72 + s0) = w; } } \
        LBAR(); \
        if (live_) { const int tt = wid & 3, vtl = wid >> 2; f32x4 acc = (f32x4){0.f, 0.f, 0.f, 0.f}; \
            unsigned ob_ = (unsigned)(dir ? 63 - (16 * tt + fr) : 16 * tt + fr) * opitch + (unsigned)(hd * 128 + 32 * vq + 16 * vtl + 4 * fq); asm volatile("" : "+v"(ob_)); \
            unsigned short* oo = dir ? xrow16(P, row0) + 1024 : slotp(P, 1) + (size_t)row0 * 1024; \
            _Pragma("unroll") for (int ks = 0; ks < 2; ++ks) acc = MFMA16(*(const bf16x8*)(VT + (16 * vtl + fr) * 72 + 32 * ks + 8 * fq), *(const bf16x8*)(Pm + (16 * tt + fr) * 72 + 32 * ks + 8 * fq), acc); \
            _Pragma("unroll") for (int ks = 0; ks < 4; ++ks) acc = MFMA16(*(const bf16x8*)(ST + (16 * vtl + fr) * 136 + 32 * ks + 8 * fq), *(const bf16x8*)(Qt + (16 * tt + fr) * 136 + 32 * ks + 8 * fq), acc); \
            uint2 w; w.x = pk2(acc[0], acc[1]); w.y = pk2(acc[2], acc[3]); *(uint2*)(oo + ob_) = w; } \
        { bf16x8 ka[2]; \
            _Pragma("unroll") for (int ks = 0; ks < 2; ++ks) ka[ks] = *(const bf16x8*)(KtT + (16 * wid + fr) * 72 + 32 * ks + 8 * fq); \
            const f32x4 dc4 = erc * elc; \
            _Pragma("unroll") for (int vt = 0; vt < 2; ++vt) { f32x4 T = (f32x4){0.f, 0.f, 0.f, 0.f}; \
                _Pragma("unroll") for (int ks = 0; ks < 2; ++ks) T = MFMA16(ka[ks], *(const bf16x8*)(VT + (16 * vt + fr) * 72 + 32 * ks + 8 * fq), T); \
                S[vt] = dc4 * S[vt] + elc * T; } } \
        LBAR(); \
        _Pragma("unroll") for (int vt = 0; vt < 2; ++vt) { const f32x4 sv = S[vt] * ERN; uint2 w; w.x = pk2(sv[0], sv[1]); w.y = pk2(sv[2], sv[3]); *(uint2*)(ST + (16 * vt + fr) * 136 + 16 * wid + 4 * fq) = w; } \
    } while (0)
    SCAN_LOAD(scan_row0(0, b, dir), qa_, ka_, va_, era, ela);
    SCAN_LOAD(scan_row0(1, b, dir), qb_r, kb_r, vb_r, erb, elb);
    __syncthreads();
    for (int c = 0; c < 68; c += 2) {
        SCAN_ITER(c, qa_, ka_, va_, era, ela, erb);
        SCAN_ITER(c + 1, qb_r, kb_r, vb_r, erb, elb, era);
    }
#undef SCAN_ITER
}
#undef SCAN_LOAD
DI void readout_phase(const Params& P, int l, int nrows, int dry, int s_of, int s_ob, int s_og) {
    const int tid_ = ltid(); const int lane = tid_ & 63, wid = tid_ >> 6;
    bf16_t* of = slotp(P, s_of); const bf16_t* og = slotp(P, s_og); const float* nw = P.in[13] + l * 128 + 16 * (lane & 7);
    for (int row = blockIdx.x * 8 + wid; row < nrows; row += gridDim.x * 8) {
        const size_t off = (size_t)row * 1024 + 16 * lane; float o[16], g[16]; const bf16_t* obr = xrow16(P, row) + 1024 + 16 * lane;
#pragma unroll
        for (int h = 0; h < 2; ++h) { const uint4 a = *(const uint4*)(of + off + 8 * h), bb = *(const uint4*)(obr + 8 * h), gg = *(const uint4*)(og + off + 8 * h);
            o[8 * h + 0] = bflo(a.x) + bflo(bb.x); o[8 * h + 1] = bfhi(a.x) + bfhi(bb.x); o[8 * h + 2] = bflo(a.y) + bflo(bb.y); o[8 * h + 3] = bfhi(a.y) + bfhi(bb.y);
            o[8 * h + 4] = bflo(a.z) + bflo(bb.z); o[8 * h + 5] = bfhi(a.z) + bfhi(bb.z); o[8 * h + 6] = bflo(a.w) + bflo(bb.w); o[8 * h + 7] = bfhi(a.w) + bfhi(bb.w);
            g[8 * h + 0] = bflo(gg.x); g[8 * h + 1] = bfhi(gg.x); g[8 * h + 2] = bflo(gg.y); g[8 * h + 3] = bfhi(gg.y); g[8 * h + 4] = bflo(gg.z); g[8 * h + 5] = bfhi(gg.z); g[8 * h + 6] = bflo(gg.w); g[8 * h + 7] = bfhi(gg.w); }
        float ss = 0.f;
#pragma unroll
        for (int j = 0; j < 16; ++j) ss += o[j] * o[j];
        ss += __shfl_xor(ss, 1); ss += __shfl_xor(ss, 2); ss += __shfl_xor(ss, 4);
        const float rstd = __builtin_amdgcn_rsqf(ss * (1.0f / 128.0f) + 1e-6f);
        float y[16];
#pragma unroll
        for (int j = 0; j < 16; ++j) y[j] = o[j] * rstd * nw[j] * g[j];
#pragma unroll
        for (int h = 0; h < 2; ++h) { uint4 w; w.x = pk2(y[8 * h], y[8 * h + 1]); w.y = pk2(y[8 * h + 2], y[8 * h + 3]); w.z = pk2(y[8 * h + 4], y[8 * h + 5]); w.w = pk2(y[8 * h + 6], y[8 * h + 7]); *(uint4*)((dry ? slotp(P, 6) : of) + off + 8 * h) = w; }
    }
}

DI void sgu_phase(const Params& P, unsigned char* lds, int l, int nrows, int dry, int s_u, int s_v) {
    const int tid = ltid(), lane = tid & 63, wid = tid >> 6, fr = lane & 15, fq = lane >> 4;
    float* stat = (float*)lds; unsigned short* vnT = (unsigned short*)(lds + 1024);
    bf16_t* up = slotp(P, s_u); const bf16_t* vp = slotp(P, s_v); const float* lnw = P.in[8] + l * 1024; const float* lnb = P.in[9] + l * 1024;
    const bf16_t* Ws = (const bf16_t*)(P.ws + WS_WS); const float* bs = P.in[11] + l * 1024;
    bf16_t* yout = dry ? slotp(P, 6) : up; const int nitems = (nrows / 128) * 8;
    const int s_ = tid >> 2, dq = (tid & 3) * 32;
    uint4 vr0, vr1, vr2, vr3; float4 sq[8];
#define SGU_FETCH(it) do { const int r0_ = ((it) >> 3) * 128, g_ = (it) & 7; const bf16_t* vs_ = vp + (size_t)(r0_ + s_) * 1024 + g_ * 128 + dq; vr0 = *(const uint4*)vs_; vr1 = *(const uint4*)(vs_ + 8); vr2 = *(const uint4*)(vs_ + 16); vr3 = *(const uint4*)(vs_ + 24); \
        if (tid < 128) { const float4* sp_ = (const float4*)((const float*)(P.ws + WS_VEC) + (size_t)(r0_ + tid) * 32); _Pragma("unroll") for (int i = 0; i < 8; ++i) sq[i] = sp_[i]; } } while (0)
    int item = blockIdx.x;
    if (item < nitems) SGU_FETCH(item);
    for (; item < nitems; item += gridDim.x) {
        const int r0 = (item >> 3) * 128, g = item & 7, t = 16 * wid + fr;
        bf16x8 a[4]; uint2 uu[8];
#pragma unroll
        for (int ks = 0; ks < 4; ++ks) a[ks] = *(const bf16x8*)(Ws + g * 16384 + (16 * wid + fr) * 128 + 32 * ks + 8 * fq);
#pragma unroll
        for (int dt = 0; dt < 8; ++dt) uu[dt] = *(const uint2*)(up + (size_t)(r0 + t) * 1024 + g * 128 + 16 * dt + 4 * fq);
        const float bt = bs[g * 128 + t];
        if (tid < 128) { float t1 = 0.f, t2 = 0.f;
#pragma unroll
            for (int i = 0; i < 8; ++i) { t1 += sq[i].x; t2 += sq[i].y; t1 += sq[i].z; t2 += sq[i].w; }
            const float mean = t1 * (1.0f / 1024.0f); const float var = t2 * (1.0f / 1024.0f) - mean * mean;
            stat[2 * tid] = mean; stat[2 * tid + 1] = __builtin_amdgcn_rsqf(fmaxf(var, 0.f) + 1e-5f); }
        __syncthreads();
        { const float mean = stat[2 * s_], rstd = stat[2 * s_ + 1]; const unsigned ww[16] = {vr0.x, vr0.y, vr0.z, vr0.w, vr1.x, vr1.y, vr1.z, vr1.w, vr2.x, vr2.y, vr2.z, vr2.w, vr3.x, vr3.y, vr3.z, vr3.w};
#pragma unroll
            for (int e = 0; e < 32; ++e) { const int d = dq + e, ch = g * 128 + d; const float x = (e & 1) ? bfhi(ww[e >> 1]) : bflo(ww[e >> 1]);
                vnT[d * 136 + (s_ ^ ((tid & 3) << 4))] = f2bf((x - mean) * rstd * lnw[ch] + lnb[ch]); } }
        __syncthreads();
        if (item + (int)gridDim.x < nitems) SGU_FETCH(item + (int)gridDim.x);
#pragma unroll
        for (int dt = 0; dt < 8; ++dt) { f32x4 acc = (f32x4){0.f, 0.f, 0.f, 0.f};
#pragma unroll
            for (int ks = 0; ks < 4; ++ks) acc = MFMA16(*(const bf16x8*)(vnT + (16 * dt + fr) * 136 + ((32 * ks + 8 * fq) ^ (((dt >> 1) & 3) << 4))), a[ks], acc);
            const size_t off = (size_t)(r0 + t) * 1024 + g * 128 + 16 * dt + 4 * fq; uint2 w;
            w.x = pk2(bflo(uu[dt].x) * (acc[0] + bt), bfhi(uu[dt].x) * (acc[1] + bt)); w.y = pk2(bflo(uu[dt].y) * (acc[2] + bt), bfhi(uu[dt].y) * (acc[3] + bt)); *(uint2*)(yout + off) = w; }
        __syncthreads();
    }
#undef SGU_FETCH
}

DI void conv_phase(const Params& P, int l, int nrows, int dry) {
    const bf16_t* a = (const bf16_t*)(P.ws + WS_ACT); bf16_t* v2 = (bf16_t*)(P.ws + WS_ACT) + (size_t)RT * DFF;
    const float* cw = P.in[19] + (size_t)l * 9 * DFF; const float* cb = P.in[20] + (size_t)l * DFF;
    const int tid0 = blockIdx.x * 512 + ltid();
    for (int idx = tid0; idx < NBATCH * 64 * 4 * (DFF / 8); idx += gridDim.x * 512) {
        const int c8 = idx % (DFF / 8), r = idx / (DFF / 8), seg = r & 3, gy = (r >> 2) & 63, b = r >> 8, c = c8 * 8, gx0 = seg * 16, rb = b * 4096 + gy * 64;
        float w[9][8], bias[8], win[3][3][8];
#pragma unroll
        for (int t = 0; t < 9; ++t) { const float4 w0 = *(const float4*)(cw + t * DFF + c), w1 = *(const float4*)(cw + t * DFF + c + 4); w[t][0] = w0.x; w[t][1] = w0.y; w[t][2] = w0.z; w[t][3] = w0.w; w[t][4] = w1.x; w[t][5] = w1.y; w[t][6] = w1.z; w[t][7] = w1.w; }
        { const float4 b0 = *(const float4*)(cb + c), b1 = *(const float4*)(cb + c + 4); bias[0] = b0.x; bias[1] = b0.y; bias[2] = b0.z; bias[3] = b0.w; bias[4] = b1.x; bias[5] = b1.y; bias[6] = b1.z; bias[7] = b1.w; }
#define CONV_FETCH(gx) do { _Pragma("unroll") for (int dy = 0; dy < 3; ++dy) { const int yy = gy + dy - 1; const bool ok = (unsigned)yy < 64u && (unsigned)(gx) < 64u; \
            const int rr_ = ok ? rb + (dy - 1) * 64 + (gx) : rb; pf[dy] = *(const uint4*)(a + (size_t)rr_ * DFF + c); if (!ok) pf[dy] = make_uint4(0u, 0u, 0u, 0u); } } while (0)
#define CONV_UNPACK(slot) do { _Pragma("unroll") for (int dy = 0; dy < 3; ++dy) { const uint4 av = pf[dy]; \
            win[dy][slot][0] = bflo(av.x); win[dy][slot][1] = bfhi(av.x); win[dy][slot][2] = bflo(av.y); win[dy][slot][3] = bfhi(av.y); win[dy][slot][4] = bflo(av.z); win[dy][slot][5] = bfhi(av.z); win[dy][slot][6] = bflo(av.w); win[dy][slot][7] = bfhi(av.w); } } while (0)
        uint4 pf[3]; uint4 vvn;
        CONV_FETCH(gx0 - 1); CONV_UNPACK(0); CONV_FETCH(gx0); CONV_UNPACK(1);
        CONV_FETCH(gx0 + 1); vvn = *(const uint4*)(v2 + (size_t)(rb + gx0) * DFF + c);
#pragma unroll
        for (int st = 0; st < 16; ++st) { const int gx = gx0 + st; const int s0 = st % 3, s1 = (st + 1) % 3, s2 = (st + 2) % 3;
            CONV_UNPACK(s2); const uint4 vv = vvn;
            if (st < 15) { CONV_FETCH(gx + 2); vvn = *(const uint4*)(v2 + (size_t)(rb + gx + 1) * DFF + c); }
            float acc[8];
#pragma unroll
            for (int j = 0; j < 8; ++j) { float t = bias[j];
#pragma unroll
                for (int dy = 0; dy < 3; ++dy) t += win[dy][s0][j] * w[dy * 3][j] + win[dy][s1][j] * w[dy * 3 + 1][j] + win[dy][s2][j] * w[dy * 3 + 2][j];
                acc[j] = t; }
            const size_t off = (size_t)(rb + gx) * DFF + c; uint4 o;
            o.x = pk2(gelu_t(acc[0]) * bflo(vv.x), gelu_t(acc[1]) * bfhi(vv.x)); o.y = pk2(gelu_t(acc[2]) * bflo(vv.y), gelu_t(acc[3]) * bfhi(vv.y));
            o.z = pk2(gelu_t(acc[4]) * bflo(vv.z), gelu_t(acc[5]) * bfhi(vv.z)); o.w = pk2(gelu_t(acc[6]) * bflo(vv.w), gelu_t(acc[7]) * bfhi(vv.w));
            *(uint4*)(dry ? (bf16_t*)(P.ws + WS_ACT) + (size_t)RT * DFF * 2 + (off & 0xFFFFF8) : v2 + off) = o; }
#undef CONV_FETCH
#undef CONV_UNPACK
    }
    for (int idx = tid0; idx < (nrows - RL) * (DFF / 8); idx += gridDim.x * 512) {
        const int row = RL + idx / (DFF / 8), c = (idx % (DFF / 8)) * 8, t = (row - RL) & 255;
        float acc[8]; { const float4 b0 = *(const float4*)(cb + c), b1 = *(const float4*)(cb + c + 4); acc[0] = b0.x; acc[1] = b0.y; acc[2] = b0.z; acc[3] = b0.w; acc[4] = b1.x; acc[5] = b1.y; acc[6] = b1.z; acc[7] = b1.w; }
        for (int dx = -1; dx <= 1; ++dx) { if ((unsigned)(t + dx) >= 256u) continue;
            const uint4 av = *(const uint4*)(a + (size_t)(row + dx) * DFF + c); const float4 w0 = *(const float4*)(cw + (4 + dx) * DFF + c), w1 = *(const float4*)(cw + (4 + dx) * DFF + c + 4);
            acc[0] += bflo(av.x) * w0.x; acc[1] += bfhi(av.x) * w0.y; acc[2] += bflo(av.y) * w0.z; acc[3] += bfhi(av.y) * w0.w; acc[4] += bflo(av.z) * w1.x; acc[5] += bfhi(av.z) * w1.y; acc[6] += bflo(av.w) * w1.z; acc[7] += bfhi(av.w) * w1.w; }
        const size_t off = (size_t)row * DFF + c; const uint4 vv = *(const uint4*)(v2 + off); uint4 o;
        o.x = pk2(gelu_t(acc[0]) * bflo(vv.x), gelu_t(acc[1]) * bfhi(vv.x)); o.y = pk2(gelu_t(acc[2]) * bflo(vv.y), gelu_t(acc[3]) * bfhi(vv.y));
        o.z = pk2(gelu_t(acc[4]) * bflo(vv.z), gelu_t(acc[5]) * bfhi(vv.z)); o.w = pk2(gelu_t(acc[6]) * bflo(vv.w), gelu_t(acc[7]) * bfhi(vv.w));
        *(uint4*)(dry ? (bf16_t*)(P.ws + WS_ACT) + (size_t)RT * DFF * 2 + (off & 0xFFFFF8) : v2 + off) = o;
    }
}

DI void final_phase(const Params& P, int dry) {
    const int tid_ = ltid(); const int lane = tid_ & 63, wid = tid_ >> 6; const float* fw = P.in[22]; const int nw_tot = gridDim.x * 8;
    for (int rowb = blockIdx.x * 8 + wid; rowb < RL; rowb += 2 * nw_tot) {
        float4 v[2][4]; const int rows[2] = {rowb, rowb + nw_tot};
#pragma unroll
        for (int r = 0; r < 2; ++r) { const int row = rows[r] < RL ? rows[r] : rowb; const uint2* xb = (const uint2*)((const bf16_t*)P.out + (size_t)row * 2048);
#pragma unroll
            for (int q = 0; q < 4; ++q) { const uint2 w = xb[q * 64 + lane]; v[r][q] = make_float4(bflo(w.x), bfhi(w.x), bflo(w.y), bfhi(w.y)); } }
        asm volatile("s_waitcnt vmcnt(0)" ::: "memory");
#pragma unroll
        for (int r = 0; r < 2; ++r) { const int row = rows[r]; if (row >= RL) continue; float4* xr = (float4*)(P.out + (size_t)row * 1024); float ss = 0.f;
#pragma unroll
            for (int q = 0; q < 4; ++q) ss += v[r][q].x * v[r][q].x + v[r][q].y * v[r][q].y + v[r][q].z * v[r][q].z + v[r][q].w * v[r][q].w;
            ss = wave_sum(ss); const float rstd = __builtin_amdgcn_rsqf(ss * (1.0f / 1024.0f) + 1e-6f);
#pragma unroll
            for (int q = 0; q < 4; ++q) { const float4 w = *(const float4*)(fw + 4 * (q * 64 + lane)); float4 o; o.x = v[r][q].x * rstd * w.x; o.y = v[r][q].y * rstd * w.y; o.z = v[r][q].z * rstd * w.z; o.w = v[r][q].w * rstd * w.w; if (!dry) xr[q * 64 + lane] = o; } }
    }
}

constexpr int N_PHASES = 26;
#ifndef PROBE_MASK
#define PROBE_MASK 0
#endif
#define PR(n) (((PROBE_MASK) >> (n)) & 1)
__global__ void __launch_bounds__(512) mega_fwd(Params P) {
    extern __shared__ __attribute__((aligned(16))) unsigned char lds[];
    cg::grid_group grid = cg::this_grid();
#define IN(k) (P.ph_lo <= (k) && (k) < P.ph_hi)
#define SEAM(k) do { if (IN(k) && IN((k) + 1)) { xcd_barrier(xb); if constexpr (PR(15)) xcd_barrier(xb); } } while (0)
    volatile LAS3 unsigned* st_words = (volatile LAS3 unsigned*)((LAS3 unsigned char*)lds + (LDS_BYTES - 16));
    if (threadIdx.x < 4) st_words[threadIdx.x] = 0u;
    __syncthreads();
    unsigned* barw = (unsigned*)(P.ws + WS_BAR);
    if (IN(0)) { if constexpr (PR(12)) { phase_prologue(P, lds); __syncthreads(); } phase_prologue(P, lds); }
    if (P.ph_lo < 0) grid.sync();
    XcdBarrier xb = xcd_barrier_post(barw, st_words);
    SEAM(0);
    const bf16_t* WinT = (const bf16_t*)(P.ws + WS_WIN);
    for (int l = 0; l < 2; ++l) {
        const int base = 1 + 12 * l; const int MP = (l == 1) ? RL : RT; const float* modl = (const float*)(P.ws + WS_MOD) + (size_t)l * 5 * 6144;
        if (IN(base + 0)) { norm_phase(P, l, 0, slotp(P, 0), RT); }
        SEAM(base + 0);
        if (IN(base + 1)) { Epi<M_H> E{}; E.o0 = slotp(P, 1); E.o1 = slotp(P, 2); E.o2 = slotp(P, 3); E.o3 = slotp(P, 4); E.gate = (const float*)(P.ws + WS_LB) + l * 2048; if constexpr (PR(1)) run_gemm<M_H>(lds, slotp(P, 0), WinT, RT, 4096, 1024, E); run_gemm<M_H>(lds, slotp(P, 0), WinT, RT, 4096, 1024, E);
            __syncthreads(); convert_weights(P, l, lds, 4, 64); }
        SEAM(base + 1);
        if (IN(base + 2)) scanprep_phase(P, lds, l);
        SEAM(base + 2);
        if (IN(base + 3)) scan_phase(P, lds, l);
        SEAM(base + 3);
        if (IN(base + 4)) { Epi<M_B> E{}; E.o0 = slotp(P, 3); E.o1 = slotp(P, 4); E.o2 = slotp(P, 5); E.o3 = slotp(P, 6); E.gate = (const float*)(P.ws + WS_VEC);
            if constexpr (PR(3)) run_gemm<M_B>(lds, slotp(P, 0), WinT + (size_t)4096 * 1024, MP, 5120, 1024, E); run_gemm<M_B>(lds, slotp(P, 0), WinT + (size_t)4096 * 1024, MP, 5120, 1024, E); }
        SEAM(base + 4);
        if (IN(base + 5)) { if constexpr (PR(4)) { readout_phase(P, l, MP, 1, 1, 0, 5); sgu_phase(P, lds, l, MP, 1, 3, 4); } if (blockIdx.x & 8) { sgu_phase(P, lds, l, MP, 0, 3, 4); readout_phase(P, l, MP, 0, 1, 0, 5); } else { readout_phase(P, l, MP, 0, 1, 0, 5); sgu_phase(P, lds, l, MP, 0, 3, 4); } }
        SEAM(base + 5);
        if (IN(base + 6)) {
            const bool early_ = (blockIdx.x & 8) != 0;
            if (l == 0 && early_) { ctx_ab_gemm(P, lds); __syncthreads(); convert_weights(P, 1, lds, 3, 0); __syncthreads(); }
            { Epi<M_WA> E{}; E.o0 = slotp(P, 5); E.g0 = slotp(P, 6); if constexpr (PR(6)) run_gemm<M_WA>(lds, slotp(P, 3), (const bf16_t*)(P.ws + WS_WA), MP, 1024, 1024, E); run_gemm<M_WA>(lds, slotp(P, 3), (const bf16_t*)(P.ws + WS_WA), RL, 1024, 1024, E); }
            { Epi<M_WB> E{}; E.o0 = slotp(P, 2); E.g0 = (const bf16_t*)((const unsigned char*)slotp(P, 6) + 1024); E.g1 = slotp(P, 5); if constexpr (PR(6)) run_gemm<M_WB>(lds, slotp(P, 1), (const bf16_t*)(P.ws + WS_WB), MP, 1024, 1024, E); run_gemm<M_WB>(lds, slotp(P, 1), (const bf16_t*)(P.ws + WS_WB), RL, 1024, 1024, E); }
            if (l == 0 && !early_) { ctx_ab_gemm(P, lds); __syncthreads(); convert_weights(P, 1, lds, 3, 0); }
        }
        SEAM(base + 6);
        if (IN(base + 7)) { Epi<M_RES> E{}; E.xl = P.out; E.xc = (float*)(P.ws + WS_CTX); E.gate = modl + 2 * 1024; E.sl = l == 0 ? P.in[0] : nullptr; E.sc = l == 0 ? P.in[2] : nullptr; const bool early_ = (blockIdx.x & 8) != 0;
            if (l == 0 && early_) { ctx_res_gemm(P, lds, slotp(P, 2) + (size_t)RL * 1024, 1024, (const bf16_t*)(P.ws + WS_WO), 1024, modl + 4 * 6144 + 2 * 1024, P.in[2]); __syncthreads(); }
            run_gemm<M_RES>(lds, slotp(P, 2), (const bf16_t*)(P.ws + WS_WO), RL, 1024, 1024, E);
            if (l == 0 && !early_) ctx_res_gemm(P, lds, slotp(P, 2) + (size_t)RL * 1024, 1024, (const bf16_t*)(P.ws + WS_WO), 1024, modl + 4 * 6144 + 2 * 1024, P.in[2]); }
        SEAM(base + 7);
        if (IN(base + 8)) { if constexpr (PR(8)) norm_phase(P, l, 1, slotp(P, 6), MP); norm_phase(P, l, 1, slotp(P, 6), MP); }
        SEAM(base + 8);
        if (IN(base + 9)) { Epi<M_UP> E{}; E.o0 = (bf16_t*)(P.ws + WS_ACT); E.o1 = (bf16_t*)(P.ws + WS_ACT) + (size_t)RT * DFF; if constexpr (PR(9)) run_gemm<M_UP>(lds, slotp(P, 6), (const bf16_t*)(P.ws + WS_WUP), MP, 2 * DFF, 1024, E); run_gemm<M_UP>(lds, slotp(P, 6), (const bf16_t*)(P.ws + WS_WUP), MP, 2 * DFF, 1024, E); }
        SEAM(base + 9);
        if (IN(base + 10)) { if constexpr (PR(10)) conv_phase(P, l, MP, 1); conv_phase(P, l, MP, 0); }
        SEAM(base + 10);
        if (IN(base + 11)) { Epi<M_RES> E{}; E.xl = P.out; E.xc = (float*)(P.ws + WS_CTX); E.gate = modl + 5 * 1024; E.sl = nullptr; E.sc = nullptr; const bool early_ = (blockIdx.x & 8) != 0;
            if (l == 0 && early_) { ctx_res_gemm(P, lds, (const bf16_t*)(P.ws + WS_ACT) + (size_t)RT * DFF + (size_t)RL * DFF, DFF, (const bf16_t*)(P.ws + WS_WDN), DFF, modl + 4 * 6144 + 5 * 1024, nullptr); __syncthreads(); }
            run_gemm<M_RES>(lds, (const bf16_t*)(P.ws + WS_ACT) + (size_t)RT * DFF, (const bf16_t*)(P.ws + WS_WDN), RL, 1024, DFF, E);
            if (l == 0 && !early_) { ctx_res_gemm(P, lds, (const bf16_t*)(P.ws + WS_ACT) + (size_t)RT * DFF + (size_t)RL * DFF, DFF, (const bf16_t*)(P.ws + WS_WDN), DFF, modl + 4 * 6144 + 5 * 1024, nullptr); } }
        SEAM(base + 11);
    }
    if (IN(25)) final_phase(P, 0);
#undef IN
#undef SEAM
}

#ifndef MULTI_LAUNCH
#define MULTI_LAUNCH 0
#endif
extern "C" void kernel_launch(void* const* d_in, const int* in_sizes, int n_in, void* d_out, int out_size, void* d_ws, size_t ws_size, hipStream_t stream) {
    static int grid = 0;
    if (grid == 0) {
        if (n_in != 23 || out_size != RL * 1024 || ws_size < WS_END) { fprintf(stderr, "kernel_launch: unexpected problem (n_in %d out %d ws %zu need %zu)\n", n_in, out_size, ws_size, (size_t)WS_END); grid = -1; return; }
        int dev = 0, cus = 0, per_cu = 0;
        hipGetDevice(&dev); hipDeviceGetAttribute(&cus, hipDeviceAttributeMultiprocessorCount, dev);
        if (hipFuncSetAttribute((const void*)mega_fwd, hipFuncAttributeMaxDynamicSharedMemorySize, LDS_BYTES) != hipSuccess) { fprintf(stderr, "kernel_launch: hipFuncSetAttribute failed\n"); grid = -1; return; }
        if (hipOccupancyMaxActiveBlocksPerMultiprocessor(&per_cu, (const void*)mega_fwd, 512, LDS_BYTES) != hipSuccess || per_cu < 1) { fprintf(stderr, "kernel_launch: occupancy query says %d blocks per CU\n", per_cu); (void)hipGetLastError(); per_cu = 1; }
        grid = cus;
        if (grid < 256) { fprintf(stderr, "kernel_launch: needs 256 CUs\n"); grid = -1; return; } grid = 256;
    }
    if (grid < 0) return;
    Params p{};
    for (int i = 0; i < 23; ++i) p.in[i] = (const float*)d_in[i];
    p.out = (float*)d_out; p.ws = (unsigned char*)d_ws;
#if MULTI_LAUNCH
    for (int k = 0; k < N_PHASES; ++k) { p.ph_lo = k; p.ph_hi = k + 1; hipLaunchKernelGGL(mega_fwd, dim3(grid), dim3(512), LDS_BYTES, stream, p); }
#else
    p.ph_lo = 0; p.ph_hi = N_PHASES;
    if (hipMemsetAsync((char*)d_ws + WS_BAR, 0, XCD_BAR_WORDS * 4, stream) != hipSuccess) { fprintf(stderr, "kernel_launch: memset of the barrier words failed\n"); return; }
    void* args[] = {&p};
    hipError_t e = hipLaunchCooperativeKernel((const void*)mega_fwd, dim3(grid), dim3(512), args, LDS_BYTES, stream);
    if (e != hipSuccess) fprintf(stderr, "cooperative launch failed: %s (grid %d)\n", hipGetErrorString(e), grid);
#endif
}
```

```cpp
#include <hip/hip_runtime.h>
#include <hip/hip_cooperative_groups.h>
#include <cstdio>
namespace cg = cooperative_groups;

constexpr int DM = 1024, NBATCH = 4, SEQL = 4096, CTXL = 256, RL = NBATCH * SEQL, RC = NBATCH * CTXL, RT = RL + RC;
constexpr int DIN = 9216, DFF = 2816;
constexpr size_t USLOT = (size_t)RT * 1024 * 2;
constexpr size_t WS_WIN = 0;
constexpr size_t WS_WA = WS_WIN + (size_t)DIN * 1024 * 2;
constexpr size_t WS_WB = WS_WA + 1024 * 1024 * 2;
constexpr size_t WS_WO = WS_WB + 1024 * 1024 * 2;
constexpr size_t WS_WUP = WS_WO + 1024 * 1024 * 2;
constexpr size_t WS_WDN = WS_WUP + (size_t)2 * DFF * 1024 * 2;
constexpr size_t WS_WS = WS_WDN + (size_t)1024 * DFF * 2;
constexpr size_t WS_MOD = WS_WS + 8 * 128 * 128 * 2;
constexpr size_t WS_LB = WS_MOD + 2 * 5 * 6144 * 4;
constexpr size_t WS_CTX = WS_LB + 2 * 2048 * 4;
constexpr size_t WS_ACT = WS_CTX + (size_t)RC * 1024 * 4;
constexpr size_t WS_BAR = WS_ACT + 7 * USLOT;
constexpr size_t WS_VEC = WS_BAR + 16384;
constexpr size_t WS_STAT = WS_VEC + (size_t)272 * 8 * 2 * 256 * 4;
constexpr size_t WS_END = WS_STAT + (size_t)RT * 2 * 4;
constexpr int LDS_BYTES = 137744;

#define DI __device__ __forceinline__
DI float bf2f(unsigned short u) { return __uint_as_float((unsigned)u << 16); }
DI float bflo(unsigned w) { return __uint_as_float(w << 16); }
DI float bfhi(unsigned w) { return __uint_as_float(w & 0xffff0000u); }
DI unsigned short f2bf(float f) { unsigned u = __float_as_uint(f); u += 0x7fffu + ((u >> 16) & 1u); return (unsigned short)(u >> 16); }
typedef __bf16 bf16v2_t __attribute__((ext_vector_type(2))); typedef float f32v2_t __attribute__((ext_vector_type(2)));
DI unsigned pk2(float lo, float hi) { const f32v2_t f = {lo, hi}; const bf16v2_t h = __builtin_convertvector(f, bf16v2_t); return __builtin_bit_cast(unsigned, h); }
DI unsigned pkh2(float a, float b) { _Float16 x = (_Float16)a, y = (_Float16)b; return (unsigned)__builtin_bit_cast(unsigned short, x) | ((unsigned)__builtin_bit_cast(unsigned short, y) << 16); }
DI float h2f(unsigned short u) { return (float)__builtin_bit_cast(_Float16, u); }
DI float fexp(float x) { return __builtin_amdgcn_exp2f(x * 1.44269504089f); }
DI float flog(float x) { return __builtin_amdgcn_logf(x) * 0.69314718056f; }
DI float sigm(float x) { return __builtin_amdgcn_rcpf(1.0f + fexp(-x)); }
DI float silu_f(float x) { return x * sigm(x); }
DI float gelu_t(float x) { return x * sigm(1.59576912161f * (x + 0.044715f * x * x * x)); }
DI float wave_sum(float v) { for (int o = 32; o >= 1; o >>= 1) v += __shfl_xor(v, o); return v; }

namespace pg8 {
#define PG8_LAS __attribute__((address_space(3)))
typedef unsigned short bf16_t;
typedef short bf16x8 __attribute__((ext_vector_type(8)));
typedef float f32x4 __attribute__((ext_vector_type(4)));
typedef unsigned u32x4 __attribute__((ext_vector_type(4)));
constexpr int BM = 256, BK = 64, HALF = 128, HTB = HALF * BK * 2  , STAGE_BYTES = 8 * HTB, NXCD = 8, WGM = 8;

__host__ __device__ __forceinline__ int lds_byte(int r, int c) { const int st = (r >> 4) * 2 + (c >> 5), rr = r & 15, cc = c & 31, ob = rr * 64 + cc * 2; return st * 1024 + (ob ^ (((ob >> 9) & 1) << 5)); }
__host__ __device__ __forceinline__ void stage_rc(int b, int& R, int& C) { const int st = b / 1024, sb = b % 1024, swz = sb ^ (((sb >> 9) & 1) << 5); R = (st >> 1) * 16 + swz / 64; C = (st & 1) * 32 + (swz % 64) / 2; }
__host__ __device__ __forceinline__ int perm32(int rho) { const int n = rho >> 4, i = rho & 15; return 8 * (i >> 2) + 4 * n + (i & 3); }

struct Unit { int pm, pn; };
struct Gemm { const bf16_t* A; const bf16_t* Bt; int M, N, K; };

struct StaticOrder {
    int nM, nN, nwg, G, c;
    __host__ __device__ void init(int M, int N, int G_, int c_) { nM = M / BM; nN = N / BM; nwg = nM * nN; G = G_; c = c_; }
    __host__ __device__ bool next(int i, Unit& u) const {
        const long L = (long)i * G + c; if (L >= nwg) return false;
        int wgid = (int)L; { const int q = nwg / NXCD, r = nwg % NXCD, xcd = wgid % NXCD, off = wgid / NXCD; wgid = (xcd < r ? xcd * (q + 1) : r * (q + 1) + (xcd - r) * q) + off; }
        const int nig = WGM * nN, gid = wgid / nig, fm = gid * WGM, gsz = (nM - fm) < WGM ? (nM - fm) : WGM;
        u.pm = fm + ((wgid % nig) % gsz); u.pn = (wgid % nig) / gsz; return true;
    }
    __device__ __forceinline__ void a_ready(const Unit&) const {}
    __device__ __forceinline__ void done(const Unit&) const {}
};
__device__ __forceinline__ unsigned cvt_pk_bf16(float lo, float hi) { unsigned r; asm volatile("v_cvt_pk_bf16_f32 %0, %1, %2" : "=v"(r) : "v"(lo), "v"(hi)); return r; }
typedef float f32x2 __attribute__((ext_vector_type(2)));
template <class Epi, class Sched, bool ALIGN_EPI = false, bool SP2 = false>
__device__ __forceinline__ void gemm_phase(PG8_LAS unsigned char* lds, const Gemm g, const Sched& S, const Epi& E) {
    int tid = threadIdx.x; asm volatile("" : "+v"(tid)); const int wid = __builtin_amdgcn_readfirstlane(tid >> 6), lane = tid & 63, wr = wid >> 2, wc = wid & 3, fr = lane & 15, fq = lane >> 4;
    const int K = g.K, nt = K / BK;
    unsigned voffA[2], voffB[2];
#pragma unroll
    for (int i = 0; i < 2; ++i) { int R, C; stage_rc(tid * 16 + i * 8192, R, C); const int Rb = Epi::PERM ? ((R & ~31) + perm32(R & 31)) : R;
        voffA[i] = (unsigned)(R * K + C) * 2u; voffB[i] = (unsigned)(Rb * K + C) * 2u; }
    const size_t kstep = (size_t)(BK * 2);
    const size_t hstep = (size_t)HALF * K * 2;
    const size_t tstep = 2 * hstep;
    const unsigned ldsw = (unsigned)wid * 1024u;
    const int aoff = lds_byte(wr * 64 + fr, fq * 8), boff = lds_byte(wc * 32 + fr, fq * 8);
#define PG8_SA(b, h) (((b) * 2 + (h)) * HTB)
#define PG8_SB(b, h) ((4 + (b) * 2 + (h)) * HTB)
#define PG8_STAGE(bufoff, gbase, voff) do { _Pragma("unroll") for (int _i = 0; _i < 2; ++_i) \
        __builtin_amdgcn_global_load_lds((const unsigned*)((const char*)(gbase) + (voff)[_i]), (PG8_LAS unsigned*)(lds + (bufoff) + ldsw + _i * 8192), 16, 0, 0); } while (0)
#define PG8_LDA(dst, b, h) do { _Pragma("unroll") for (int m = 0; m < 4; ++m) _Pragma("unroll") for (int k = 0; k < 2; ++k) dst[m][k] = *(const PG8_LAS bf16x8*)(lds + PG8_SA(b, h) + aoff + m * 2048 + k * 1024); } while (0)
#define PG8_LDB(dst, b, h) do { _Pragma("unroll") for (int n = 0; n < 2; ++n) _Pragma("unroll") for (int k = 0; k < 2; ++k) dst[n][k] = *(const PG8_LAS bf16x8*)(lds + PG8_SB(b, h) + boff + n * 2048 + k * 1024); } while (0)
#define PG8_MMA(ai, bj, At, Bt) do { __builtin_amdgcn_s_setprio(1); _Pragma("unroll") for (int m = 0; m < 4; ++m) _Pragma("unroll") for (int n = 0; n < 2; ++n) _Pragma("unroll") for (int k = 0; k < 2; ++k) \
        acc[ai][bj][m][n] = __builtin_amdgcn_mfma_f32_16x16x32_bf16(Bt[n][k], At[m][k], acc[ai][bj][m][n], 0, 0, 0); __builtin_amdgcn_s_setprio(0); } while (0)
#define PG8_WAIT_V(n) asm volatile("s_waitcnt vmcnt(" #n ")" ::: "memory")
#define PG8_WAIT_L(n) asm volatile("s_waitcnt lgkmcnt(" #n ")" ::: "memory")
#define PG8_BAR __builtin_amdgcn_s_barrier()
#define PG8_SCHED __builtin_amdgcn_sched_barrier(0)
    Unit cur, nxt; int ui = 0;
    if (!S.next(0, cur)) return;
    f32x4 acc[2][2][4][2];
#pragma unroll
    for (int a = 0; a < 2; ++a)
#pragma unroll
        for (int b = 0; b < 2; ++b)
#pragma unroll
            for (int m = 0; m < 4; ++m)
#pragma unroll
                for (int n = 0; n < 2; ++n) acc[a][b][m][n] = (f32x4){0.f, 0.f, 0.f, 0.f};
    bf16x8 At[4][2], B0[2][2], B1[2][2];
    const char* cA = (const char*)g.A + (size_t)cur.pm * tstep; const char* cB = (const char*)g.Bt + (size_t)cur.pn * tstep;
    S.a_ready(cur);
    if constexpr (SP2) {
        PG8_STAGE(PG8_SB(0, 0), cB, voffB); PG8_STAGE(PG8_SB(0, 1), cB + hstep, voffB); PG8_STAGE(PG8_SA(0, 0), cA, voffA); PG8_STAGE(PG8_SA(0, 1), cA + hstep, voffA);
        if (wr == 1) PG8_BAR;
        PG8_WAIT_V(2); PG8_BAR;
        PG8_STAGE(PG8_SB(1, 0), cB + kstep, voffB); PG8_STAGE(PG8_SA(1, 0), cA + kstep, voffA); PG8_STAGE(PG8_SB(1, 1), cB + hstep + kstep, voffB);
        PG8_WAIT_V(6); PG8_BAR;
    } else {
        PG8_STAGE(PG8_SB(0, 0), cB, voffB); PG8_STAGE(PG8_SA(0, 0), cA, voffA); PG8_STAGE(PG8_SB(0, 1), cB + hstep, voffB); PG8_STAGE(PG8_SA(0, 1), cA + hstep, voffA);
        if (wr == 1) PG8_BAR;
        PG8_WAIT_V(4); PG8_BAR;
        PG8_STAGE(PG8_SB(1, 0), cB + kstep, voffB); PG8_STAGE(PG8_SA(1, 0), cA + kstep, voffA); PG8_STAGE(PG8_SB(1, 1), cB + hstep + kstep, voffB);
        PG8_WAIT_V(6); PG8_BAR;
    }
    for (;;) {
        const bool has_next = S.next(ui + 1, nxt);
        const char* nA = has_next ? (const char*)g.A + (size_t)nxt.pm * tstep : cA; const char* nB = has_next ? (const char*)g.Bt + (size_t)nxt.pn * tstep : cB;
        for (int t = 0; t < nt; t += 2) {
            const bool last = (t == nt - 2);
            const char* a1 = cA + (size_t)(t + 1) * kstep;
            const char* a2 = last ? nA : cA + (size_t)(t + 2) * kstep; const char* b2 = last ? nB : cB + (size_t)(t + 2) * kstep;
            const char* a3 = a2 + kstep; const char* b3 = b2 + kstep;
            if (last && has_next) S.a_ready(nxt);
            if constexpr (SP2) {
            PG8_LDB(B0, 0, 0); PG8_LDB(B1, 0, 1); PG8_SCHED; PG8_LDA(At, 0, 0); PG8_STAGE(PG8_SA(1, 1), a1 + hstep, voffA);
            PG8_WAIT_V(8); PG8_WAIT_L(0); PG8_BAR; PG8_MMA(0, 0, At, B0); PG8_MMA(0, 1, At, B1); PG8_BAR; PG8_SCHED;
            PG8_LDA(At, 0, 1); PG8_STAGE(PG8_SB(0, 0), b2, voffB); PG8_STAGE(PG8_SB(0, 1), b2 + hstep, voffB); PG8_STAGE(PG8_SA(0, 0), a2, voffA);
            PG8_WAIT_V(8); PG8_WAIT_L(0); PG8_BAR; PG8_MMA(1, 0, At, B0); PG8_MMA(1, 1, At, B1); PG8_BAR; PG8_SCHED;
            PG8_LDB(B0, 1, 0); PG8_LDB(B1, 1, 1); PG8_SCHED; PG8_LDA(At, 1, 0); PG8_STAGE(PG8_SA(0, 1), a2 + hstep, voffA);
            PG8_WAIT_V(8); PG8_WAIT_L(0); PG8_BAR; PG8_MMA(0, 0, At, B0); PG8_MMA(0, 1, At, B1); PG8_BAR; PG8_SCHED;
            PG8_LDA(At, 1, 1); PG8_STAGE(PG8_SB(1, 0), b3, voffB); PG8_STAGE(PG8_SB(1, 1), b3 + hstep, voffB); PG8_STAGE(PG8_SA(1, 0), a3, voffA);
            PG8_WAIT_V(8); PG8_WAIT_L(0); PG8_BAR; PG8_MMA(1, 0, At, B0); PG8_MMA(1, 1, At, B1); PG8_BAR; PG8_SCHED;
            } else {
            PG8_LDB(B0, 0, 0); PG8_SCHED; PG8_LDA(At, 0, 0); PG8_STAGE(PG8_SA(1, 1), a1 + hstep, voffA);
            PG8_WAIT_L(8); PG8_BAR; PG8_WAIT_L(0); PG8_MMA(0, 0, At, B0); PG8_BAR; PG8_SCHED;
            PG8_LDB(B1, 0, 1); PG8_STAGE(PG8_SB(0, 0), b2, voffB);
            PG8_BAR; PG8_WAIT_L(0); PG8_MMA(0, 1, At, B1); PG8_BAR;
            PG8_LDA(At, 0, 1); PG8_STAGE(PG8_SA(0, 0), a2, voffA);
            PG8_BAR; PG8_WAIT_L(0); PG8_MMA(1, 0, At, B0); PG8_BAR; PG8_SCHED;
            PG8_STAGE(PG8_SB(0, 1), b2 + hstep, voffB);
            PG8_WAIT_V(6); PG8_BAR; PG8_MMA(1, 1, At, B1); PG8_BAR;
            PG8_LDB(B0, 1, 0); PG8_SCHED; PG8_LDA(At, 1, 0); PG8_STAGE(PG8_SA(0, 1), a2 + hstep, voffA);
            PG8_WAIT_L(8); PG8_BAR; PG8_WAIT_L(0); PG8_MMA(0, 0, At, B0); PG8_BAR; PG8_SCHED;
            PG8_LDB(B1, 1, 1); PG8_STAGE(PG8_SB(1, 0), b3, voffB);
            PG8_BAR; PG8_WAIT_L(0); PG8_MMA(0, 1, At, B1); PG8_BAR;
            PG8_LDA(At, 1, 1); PG8_STAGE(PG8_SA(1, 0), a3, voffA);
            PG8_BAR; PG8_WAIT_L(0); PG8_MMA(1, 0, At, B0); PG8_BAR; PG8_SCHED;
            PG8_STAGE(PG8_SB(1, 1), b3 + hstep, voffB);
            PG8_WAIT_V(6); PG8_BAR; PG8_MMA(1, 1, At, B1); PG8_BAR;
            }
        }
        if constexpr (ALIGN_EPI) { if (wr == 0) PG8_BAR; }
        if constexpr (!Epi::AFTER_DRAIN) { E(acc, cur, wr, wc, fr, fq); S.done(cur); }
        if (!has_next) break;
#pragma unroll
        for (int a = 0; a < 2; ++a)
#pragma unroll
            for (int b = 0; b < 2; ++b)
#pragma unroll
                for (int m = 0; m < 4; ++m)
#pragma unroll
                    for (int n = 0; n < 2; ++n) acc[a][b][m][n] = (f32x4){0.f, 0.f, 0.f, 0.f};
        cur = nxt; cA = nA; cB = nB; ++ui;
        if constexpr (ALIGN_EPI) { if (wr == 1) PG8_BAR; }
    }
    PG8_WAIT_V(0);
    if constexpr (!ALIGN_EPI) { if (wr == 0) PG8_BAR; }
    PG8_BAR;
    if constexpr (Epi::AFTER_DRAIN) { E.fused(acc, cur, wr, wc, fr, fq, lds, wid, lane); S.done(cur); }
#undef PG8_SA
#undef PG8_SB
#undef PG8_STAGE
#undef PG8_LDA
#undef PG8_LDB
#undef PG8_MMA
#undef PG8_WAIT_V
#undef PG8_WAIT_L
#undef PG8_BAR
#undef PG8_SCHED
}

}
#define LAS __attribute__((address_space(3)))
#define XB_TMO      128
#define XB_XCNT(j)  (256  + 64 * (j))
#define XB_XSUB(j)  (1280 + 64 * (j))
#define XB_XGEN(j)  (2304 + 64 * (j))
#define XB_TOP      3328
#define XB_TOPGEN   3392
#define XCD_BAR_WORDS 3456
#define XB_SPIN_CAP (1u << 18)
__device__ __forceinline__ unsigned xb_ld(unsigned* p)              { return __hip_atomic_load(p, __ATOMIC_RELAXED, __HIP_MEMORY_SCOPE_AGENT); }
__device__ __forceinline__ unsigned xb_add(unsigned* p, unsigned v) { return __hip_atomic_fetch_add(p, v, __ATOMIC_RELAXED, __HIP_MEMORY_SCOPE_AGENT); }
__device__ __forceinline__ unsigned xb_xcc_id() { return (unsigned)__builtin_amdgcn_s_getreg((3 << 11) | 20) & 0xFu; }
#define XB_SPIN(cond, bar) do { unsigned _sp = 0; while (cond) { __builtin_amdgcn_s_sleep(1); \
    if ((++_sp & 255u) == 0u) { if (xb_ld(&(bar)[XB_TMO])) break; if (_sp > XB_SPIN_CAP) { atomicAdd(&(bar)[XB_TMO], 1u); break; } } } } while (0)

struct XcdBarrier {
    unsigned* bar; unsigned x;
    volatile LAS unsigned* st;
};

__device__ __forceinline__ XcdBarrier xcd_barrier_post(unsigned* bar, volatile LAS unsigned* st) {
    XcdBarrier b; b.bar = bar; b.x = xb_xcc_id(); b.st = st;
    if (threadIdx.x == 0) (void)xb_add(&bar[XB_XCNT(b.x)], 1u);
    return b;
}
__device__ __forceinline__ void xcd_barrier_complete(unsigned* bar, unsigned x, unsigned& nloc, unsigned& nx) {
    const unsigned G = gridDim.x * gridDim.y * gridDim.z;
    unsigned sum, cnt, mine, sp = 0u;
    for (;;) {
        sum = 0u; cnt = 0u; mine = 0u;
#pragma unroll
        for (unsigned j = 0; j < 16; ++j) { const unsigned c = xb_ld(&bar[XB_XCNT(j)]); sum += c; cnt += (c > 0u) ? 1u : 0u; mine = (j == x) ? c : mine; }
        if (sum == G) break;
        __builtin_amdgcn_s_sleep(1);
        if ((++sp & 255u) == 0u) { if (xb_ld(&bar[XB_TMO])) break; if (sp > XB_SPIN_CAP) { atomicAdd(&bar[XB_TMO], 1u); break; } }
    }
    nloc = mine > 0u ? mine : 1u; nx = cnt > 0u ? cnt : 1u;
}

__device__ __forceinline__ void xcd_barrier(const XcdBarrier& b) {
    asm volatile("s_waitcnt vmcnt(0)" ::: "memory");
    __syncthreads();
    if (threadIdx.x == 0) {
        unsigned* bar = b.bar;
        __builtin_amdgcn_s_waitcnt(0);
        unsigned nloc = b.st[0], nx = b.st[1];
        if (nloc == 0u) { xcd_barrier_complete(bar, b.x, nloc, nx); b.st[0] = nloc; b.st[1] = nx; }
        const unsigned old = xb_add(&bar[XB_XSUB(b.x)], 1u);
        const unsigned gen = old / nloc;
        if (old + 1u == (gen + 1u) * nloc) {
            __builtin_amdgcn_fence(__ATOMIC_RELEASE, "agent");
            asm volatile("s_waitcnt vmcnt(0)" ::: "memory");
            const unsigned og = xb_add(&bar[XB_TOP], 1u);
            const unsigned tg = og / nx;
            if (og + 1u == (tg + 1u) * nx) xb_add(&bar[XB_TOPGEN], 1u);
            else XB_SPIN(xb_ld(&bar[XB_TOPGEN]) == tg, bar);
            __builtin_amdgcn_fence(__ATOMIC_ACQUIRE, "agent");
            xb_add(&bar[XB_XGEN(b.x)], 1u);
            asm volatile("s_waitcnt vmcnt(0)" ::: "memory");
        } else {
            XB_SPIN(xb_ld(&bar[XB_XGEN(b.x)]) == gen, bar);
            __builtin_amdgcn_fence(__ATOMIC_ACQUIRE, "agent");
            asm volatile("s_waitcnt vmcnt(0)" ::: "memory");
        }
    }
    __syncthreads();
}

using pg8::bf16_t; using pg8::bf16x8; using pg8::f32x4; using pg8::u32x4; typedef unsigned u32x2 __attribute__((ext_vector_type(2))); using pg8::Unit; using pg8::Gemm; using pg8::StaticOrder;
#define LAS3 __attribute__((address_space(3)))
DI int ltid() { int t = threadIdx.x; asm volatile("" : "+v"(t)); return t; }
#define LBAR() do { asm volatile("s_waitcnt lgkmcnt(0)" ::: "memory"); __builtin_amdgcn_s_barrier(); asm volatile("" ::: "memory"); } while (0)
DI float4 ntload4(const float* p) { const f32x4 t = __builtin_nontemporal_load((const f32x4*)p); return make_float4(t[0], t[1], t[2], t[3]); }
#define MFMA16(a, b, c) __builtin_amdgcn_mfma_f32_16x16x32_bf16((a), (b), (c), 0, 0, 0)

struct Params { const float* in[23]; float* out; unsigned char* ws; int ph_lo, ph_hi; };

DI bf16_t* slotp(const Params& P, int s) { return (bf16_t*)(P.ws + WS_ACT + (size_t)s * USLOT); }
DI bf16_t* xrow16(const Params& P, int row) { return row < RL ? (bf16_t*)P.out + (size_t)row * 2048 : (bf16_t*)(P.ws + WS_CTX) + (size_t)(row - RL) * 2048; }

enum { M_H = 0, M_B = 1, M_GATES = 2, M_WA = 3, M_WB = 4, M_UP = 5, M_RES = 6 };
template <int MODE> struct Epi {
    static constexpr bool PERM = true, AFTER_DRAIN = false;
    bf16_t* o0; bf16_t* o1; bf16_t* o2; bf16_t* o3;
    const bf16_t* g0; const bf16_t* g1;
    float* xl; float* xc; const float* gate; float* dryp; const float* sl; const float* sc;
    __device__ __forceinline__ void operator()(const f32x4 (&acc)[2][2][4][2], const Unit& u, int wr, int wc, int fr, int fq) const {
        if constexpr (MODE == M_RES) {
            const int row0 = u.pm * 256 + wr * 64 + fr, colb = u.pn * 256 + wc * 32 + 8 * fq;
            const int mi = (u.pm * 256 < RL) ? ((u.pm * 256) >> 12) : 4; const float* gr = gate + mi * 6144 + colb;
            const f32x4 g00 = *(const f32x4*)gr, g01 = *(const f32x4*)(gr + 4), g10 = *(const f32x4*)(gr + 128), g11 = *(const f32x4*)(gr + 132);
#pragma unroll
            for (int ai = 0; ai < 2; ++ai)
#pragma unroll
                for (int mp = 0; mp < 2; ++mp) {
                    f32x4 xa[2][2][2]; bf16_t* xdp[2];
#pragma unroll
                    for (int mm = 0; mm < 2; ++mm) { const int row = row0 + ai * 128 + (2 * mp + mm) * 16;
                        bf16_t* xd = row < RL ? (bf16_t*)xl + (size_t)row * 2048 : (bf16_t*)xc + (size_t)(row - RL) * 2048; xdp[mm] = xd;
                        if (sl) { const float* xs = (row < RL ? sl + (size_t)row * 1024 : sc + (size_t)(row - RL) * 1024) + colb;
#pragma unroll
                            for (int bj = 0; bj < 2; ++bj) { xa[mm][bj][0] = *(const f32x4*)(xs + bj * 128); xa[mm][bj][1] = *(const f32x4*)(xs + bj * 128 + 4); } }
                        else {
#pragma unroll
                            for (int bj = 0; bj < 2; ++bj) { const u32x4 xw = *(const u32x4*)(xd + colb + bj * 128); xa[mm][bj][0] = (f32x4){bflo(xw.x), bfhi(xw.x), bflo(xw.y), bfhi(xw.y)}; xa[mm][bj][1] = (f32x4){bflo(xw.z), bfhi(xw.z), bflo(xw.w), bfhi(xw.w)}; } } }
#pragma unroll
                    for (int mm = 0; mm < 2; ++mm)
#pragma unroll
                        for (int bj = 0; bj < 2; ++bj) { const int m = 2 * mp + mm;
                            const f32x4 x0 = xa[mm][bj][0] + (bj ? g10 : g00) * acc[ai][bj][m][0], x1 = xa[mm][bj][1] + (bj ? g11 : g01) * acc[ai][bj][m][1];
                            u32x4 w; w.x = pk2(x0[0], x0[1]); w.y = pk2(x0[2], x0[3]); w.z = pk2(x1[0], x1[1]); w.w = pk2(x1[2], x1[3]); *(u32x4*)(xdp[mm] + colb + bj * 128) = w; }
                    asm volatile("" ::: "memory");
                }
        } else {
            const int row0 = u.pm * 256 + wr * 64 + fr;
            int part = 0, colt = u.pn * 256, ld = 1024; bf16_t* ob = o0;
            if constexpr (MODE == M_H || MODE == M_B || MODE == M_GATES) { part = u.pn >> 2; colt = (u.pn & 3) * 256; ob = part == 0 ? o0 : (part == 1 ? o1 : (part == 2 ? o2 : o3)); }
            if constexpr (MODE == M_UP) { ld = DFF; if (u.pn >= 11) { ob = o1; colt = (u.pn - 11) * 256; } }
#pragma unroll
            for (int ai = 0; ai < 2; ++ai)
#pragma unroll
                for (int m = 0; m < 4; ++m) {
                    const int row = row0 + ai * 128 + m * 16; float st1 = 0.f, st2 = 0.f;
#pragma unroll
                    for (int bj = 0; bj < 2; ++bj) {
                        const int col = colt + bj * 128 + wc * 32 + 8 * fq; const size_t off = (size_t)row * ld + col;
                        float v[8]; { const f32x4 a = acc[ai][bj][m][0], b = acc[ai][bj][m][1]; v[0] = a[0]; v[1] = a[1]; v[2] = a[2]; v[3] = a[3]; v[4] = b[0]; v[5] = b[1]; v[6] = b[2]; v[7] = b[3]; }
                        u32x4 w;
                        if constexpr (MODE == M_H) {
                            if (part == 1 || part == 2) { const float* lbp = gate + (part - 1) * 1024 + col; const f32x4 l0 = *(const f32x4*)lbp, l1 = *(const f32x4*)(lbp + 4); const float lbv[8] = {l0[0], l0[1], l0[2], l0[3], l1[0], l1[1], l1[2], l1[3]};
#pragma unroll
                                for (int j = 0; j < 8; ++j) v[j] = fmaxf(__builtin_amdgcn_logf(lbv[j] + (1.0f - lbv[j]) * sigm(v[j])), -43.0f);
                                w.x = pkh2(v[0], v[1]); w.y = pkh2(v[2], v[3]); w.z = pkh2(v[4], v[5]); w.w = pkh2(v[6], v[7]); }
                            else { if (part == 0) {
#pragma unroll
                                    for (int j = 0; j < 8; ++j) v[j] = silu_f(v[j]); }
                                w.x = pk2(v[0], v[1]); w.y = pk2(v[2], v[3]); w.z = pk2(v[4], v[5]); w.w = pk2(v[6], v[7]); }
                        } else {
                            if constexpr (MODE == M_B) {
                                if (part >= 3) { unsigned q[8];
#pragma unroll
                                    for (int j = 0; j < 8; ++j) q[j] = (unsigned)(sigm(v[j]) * 255.0f + 0.5f);
                                    u32x2 wb; wb.x = q[0] | (q[1] << 8) | (q[2] << 16) | (q[3] << 24); wb.y = q[4] | (q[5] << 8) | (q[6] << 16) | (q[7] << 24);
                                    *(u32x2*)((unsigned char*)o3 + (size_t)row * 2048 + (part - 3) * 1024 + col) = wb; continue; }
                                if (part == 2) {
#pragma unroll
                                    for (int j = 0; j < 8; ++j) v[j] = silu_f(v[j]); }
                                else {
#pragma unroll
                                    for (int j = 0; j < 8; ++j) v[j] = gelu_t(v[j]);
                                    if (part == 1) { float s1 = 0.f, s2 = 0.f;
#pragma unroll
                                        for (int j = 0; j < 8; ++j) { s1 += v[j]; s2 += v[j] * v[j]; }
                                        st1 += s1; st2 += s2; } } }
                            if constexpr (MODE == M_GATES) {
#pragma unroll
                                for (int j = 0; j < 8; ++j) v[j] = sigm(v[j]); }
                            if constexpr (MODE == M_WA || MODE == M_WB) {
                                const u32x2 gw = *(const u32x2*)((const unsigned char*)g0 + (size_t)row * 2048 + col);
                                constexpr float I255 = 1.0f / 255.0f;
                                v[0] *= (float)(gw.x & 255u) * I255; v[1] *= (float)((gw.x >> 8) & 255u) * I255; v[2] *= (float)((gw.x >> 16) & 255u) * I255; v[3] *= (float)(gw.x >> 24) * I255;
                                v[4] *= (float)(gw.y & 255u) * I255; v[5] *= (float)((gw.y >> 8) & 255u) * I255; v[6] *= (float)((gw.y >> 16) & 255u) * I255; v[7] *= (float)(gw.y >> 24) * I255; }
                            if constexpr (MODE == M_WB) {
                                const u32x4 tw = *(const u32x4*)(g1 + off);
                                v[0] += bflo(tw.x); v[1] += bfhi(tw.x); v[2] += bflo(tw.y); v[3] += bfhi(tw.y); v[4] += bflo(tw.z); v[5] += bfhi(tw.z); v[6] += bflo(tw.w); v[7] += bfhi(tw.w); }
                            w.x = pk2(v[0], v[1]); w.y = pk2(v[2], v[3]); w.z = pk2(v[4], v[5]); w.w = pk2(v[6], v[7]);
                        }
                        *(u32x4*)(ob + off) = w;
                    }
                    if constexpr (MODE == M_B) { if (part == 1) { st1 += __shfl_xor(st1, 16); st1 += __shfl_xor(st1, 32); st2 += __shfl_xor(st2, 16); st2 += __shfl_xor(st2, 32);
                            if (fq == 0) { float* sp = (float*)gate + ((size_t)row * 16 + (u.pn & 3) * 4 + wc) * 2; *(float2*)sp = make_float2(st1, st2); } } }
                    if (!(MODE == M_WA || MODE == M_WB) || (m & 1)) asm volatile("" ::: "memory");
                }
        }
    }
};

template <int MODE> DI void run_gemm(unsigned char* lds, const bf16_t* A, const bf16_t* Bt, int M, int N, int K, const Epi<MODE>& E) {
    Gemm g{A, Bt, M, N, K}; StaticOrder S; S.init(M, N, (int)gridDim.x, (int)blockIdx.x);
    pg8::gemm_phase<Epi<MODE>, StaticOrder, true, true>((LAS3 unsigned char*)lds, g, S, E);
}

DI void ctx_res_gemm(const Params& P, unsigned char* lds, const bf16_t* A, int lda, const bf16_t* Bt, int K, const float* gate, const float* xsrc_f32) {
    const int tid = ltid(), lane = tid & 63, wid = tid >> 6, fr = lane & 15, fq = lane >> 4;
    unsigned short* LA = (unsigned short*)lds; unsigned short* LB = LA + 64 * 264;
    for (int tile = blockIdx.x; tile < 256; tile += gridDim.x) {
        const int tm = tile >> 4, tn = tile & 15;
        const bf16_t* ag = A + (size_t)(tm * 64) * lda; const bf16_t* bg = Bt + (size_t)(tn * 64) * K;
        uint4 ra0, ra1, ra2, ra3, rb0, rb1, rb2, rb3;
        const int pr_ = tid >> 5, pc_ = (tid & 31) * 8;
#define CTX_FETCH(k0) do { const bf16_t* a_ = ag + (size_t)pr_ * lda + (k0) + pc_; const bf16_t* b_ = bg + (size_t)pr_ * K + (k0) + pc_; \
            ra0 = *(const uint4*)a_; ra1 = *(const uint4*)(a_ + (size_t)16 * lda); ra2 = *(const uint4*)(a_ + (size_t)32 * lda); ra3 = *(const uint4*)(a_ + (size_t)48 * lda); \
            rb0 = *(const uint4*)b_; rb1 = *(const uint4*)(b_ + (size_t)16 * K); rb2 = *(const uint4*)(b_ + (size_t)32 * K); rb3 = *(const uint4*)(b_ + (size_t)48 * K); } while (0)
        CTX_FETCH(0);
        f32x4 acc0 = (f32x4){0.f, 0.f, 0.f, 0.f}, acc1 = acc0;
        for (int k = 0; k < K; k += 256) {
            __syncthreads();
            { unsigned short* la_ = LA + pr_ * 264 + pc_; unsigned short* lb_ = LB + pr_ * 264 + pc_;
                *(uint4*)la_ = ra0; *(uint4*)(la_ + 16 * 264) = ra1; *(uint4*)(la_ + 32 * 264) = ra2; *(uint4*)(la_ + 48 * 264) = ra3;
                *(uint4*)lb_ = rb0; *(uint4*)(lb_ + 16 * 264) = rb1; *(uint4*)(lb_ + 32 * 264) = rb2; *(uint4*)(lb_ + 48 * 264) = rb3; }
            __syncthreads();
            if (k + 256 < K) CTX_FETCH(k + 256);
            bf16x8 a[8], b0[8], b1[8];
#pragma unroll
            for (int j = 0; j < 8; ++j) { a[j] = *(const bf16x8*)(LA + (16 * (wid & 3) + fr) * 264 + 32 * j + 8 * fq); b0[j] = *(const bf16x8*)(LB + (32 * (wid >> 2) + fr) * 264 + 32 * j + 8 * fq); b1[j] = *(const bf16x8*)(LB + (32 * (wid >> 2) + 16 + fr) * 264 + 32 * j + 8 * fq); }
#pragma unroll
            for (int j = 0; j < 8; ++j) { acc0 = MFMA16(b0[j], a[j], acc0); acc1 = MFMA16(b1[j], a[j], acc1); }
        }
#undef CTX_FETCH
        const int row = tm * 64 + 16 * (wid & 3) + fr, c0 = tn * 64 + 32 * (wid >> 2); bf16_t* xd = (bf16_t*)(P.ws + WS_CTX) + (size_t)row * 2048;
#pragma unroll
        for (int e = 0; e < 2; ++e) { const int col = c0 + 16 * e + 4 * fq; const f32x4 acc = e ? acc1 : acc0; const f32x4 gv = *(const f32x4*)(gate + col); f32x4 xv;
            if (xsrc_f32) xv = *(const f32x4*)(xsrc_f32 + (size_t)row * 1024 + col);
            else { const uint2 xw = *(const uint2*)(xd + col); xv = (f32x4){bflo(xw.x), bfhi(xw.x), bflo(xw.y), bfhi(xw.y)}; }
            xv = xv + gv * acc; uint2 w; w.x = pk2(xv[0], xv[1]); w.y = pk2(xv[2], xv[3]); *(uint2*)(xd + col) = w; }
    }
}

DI void ctx_ab_gemm(const Params& P, unsigned char* lds) {
    const int tid = ltid(), lane = tid & 63, wid = tid >> 6, fr = lane & 15, fq = lane >> 4;
    unsigned short* LA = (unsigned short*)lds; unsigned short* LB = LA + 64 * 264;
    const bf16_t* ya = slotp(P, 3) + (size_t)RL * 1024; const bf16_t* yb = slotp(P, 1) + (size_t)RL * 1024;
    const bf16_t* Wa = (const bf16_t*)(P.ws + WS_WA); const bf16_t* Wb = (const bf16_t*)(P.ws + WS_WB);
    const int pr_ = tid >> 5, pc_ = (tid & 31) * 8;
    for (int tile = blockIdx.x; tile < 256; tile += gridDim.x) {
        const int tm = tile >> 4, tn = tile & 15;
        uint4 ra0, ra1, ra2, ra3, rb0, rb1, rb2, rb3;
#define AB_FETCH(si) do { const bf16_t* a_ = (((si) >> 2) ? yb : ya) + (size_t)(tm * 64 + pr_) * 1024 + ((si) & 3) * 256 + pc_; const bf16_t* b_ = (((si) >> 2) ? Wb : Wa) + (size_t)(tn * 64 + pr_) * 1024 + ((si) & 3) * 256 + pc_; \
            ra0 = *(const uint4*)a_; ra1 = *(const uint4*)(a_ + 16 * 1024); ra2 = *(const uint4*)(a_ + 32 * 1024); ra3 = *(const uint4*)(a_ + 48 * 1024); \
            rb0 = *(const uint4*)b_; rb1 = *(const uint4*)(b_ + 16 * 1024); rb2 = *(const uint4*)(b_ + 32 * 1024); rb3 = *(const uint4*)(b_ + 48 * 1024); } while (0)
        AB_FETCH(0);
        f32x4 acc[2][2];
        acc[0][0] = (f32x4){0.f, 0.f, 0.f, 0.f}; acc[0][1] = acc[0][0]; acc[1][0] = acc[0][0]; acc[1][1] = acc[0][0];
#pragma unroll
        for (int si = 0; si < 8; ++si) {
            __syncthreads();
            { unsigned short* la_ = LA + pr_ * 264 + pc_; unsigned short* lb_ = LB + pr_ * 264 + pc_;
                *(uint4*)la_ = ra0; *(uint4*)(la_ + 16 * 264) = ra1; *(uint4*)(la_ + 32 * 264) = ra2; *(uint4*)(la_ + 48 * 264) = ra3;
                *(uint4*)lb_ = rb0; *(uint4*)(lb_ + 16 * 264) = rb1; *(uint4*)(lb_ + 32 * 264) = rb2; *(uint4*)(lb_ + 48 * 264) = rb3; }
            __syncthreads();
            if (si + 1 < 8) AB_FETCH(si + 1);
            bf16x8 a[8], b0[8], b1[8];
#pragma unroll
            for (int j = 0; j < 8; ++j) { a[j] = *(const bf16x8*)(LA + (16 * (wid & 3) + fr) * 264 + 32 * j + 8 * fq); b0[j] = *(const bf16x8*)(LB + (32 * (wid >> 2) + fr) * 264 + 32 * j + 8 * fq); b1[j] = *(const bf16x8*)(LB + (32 * (wid >> 2) + 16 + fr) * 264 + 32 * j + 8 * fq); }
#pragma unroll
            for (int j = 0; j < 8; ++j) { acc[si >> 2][0] = MFMA16(b0[j], a[j], acc[si >> 2][0]); acc[si >> 2][1] = MFMA16(b1[j], a[j], acc[si >> 2][1]); }
        }
#undef AB_FETCH
        const int grow = RL + tm * 64 + 16 * (wid & 3) + fr, c0 = tn * 64 + 32 * (wid >> 2);
        const unsigned char* gp = (const unsigned char*)slotp(P, 6) + (size_t)grow * 2048; bf16_t* md = slotp(P, 2) + (size_t)grow * 1024; constexpr float I255 = 1.0f / 255.0f;
#pragma unroll
        for (int e = 0; e < 2; ++e) { const int col = c0 + 16 * e + 4 * fq; const unsigned ga = *(const unsigned*)(gp + col), gb = *(const unsigned*)(gp + 1024 + col);
            const f32x4 A = acc[0][e], B = acc[1][e]; float m[4];
#pragma unroll
            for (int i = 0; i < 4; ++i) m[i] = (float)((ga >> (8 * i)) & 255u) * I255 * A[i] + (float)((gb >> (8 * i)) & 255u) * I255 * B[i];
            uint2 w; w.x = pk2(m[0], m[1]); w.y = pk2(m[2], m[3]); *(uint2*)(md + col) = w; }
    }
}

struct ConvItem { const float* src; bf16_t* dst; int K, N, tile; };
constexpr int CV_IN = 16 * 144, CV_SQ = 256, CV_UP = 16 * 88, CV_DN = 44 * 16, CV_WS = 32;
constexpr int CV_E0 = CV_IN, CV_E1 = CV_E0 + CV_SQ, CV_E2 = CV_E1 + CV_SQ, CV_E3 = CV_E2 + CV_SQ, CV_E4 = CV_E3 + CV_UP, CV_E5 = CV_E4 + CV_DN, CV_E6 = CV_E5 + CV_WS;
DI bool conv_item(const Params& P, int l, int it, int sel, ConvItem& c) {
    if (it >= CV_E5) return false;
    const bool is_dn = (it >= CV_E4), is_in = it < CV_E0; if ((sel == 1 && is_dn) || (sel == 2 && !is_dn) || (sel == 3 && !is_in) || (sel == 4 && is_in)) return false;
    if (it < CV_E0) { c.src = P.in[7] + (size_t)l * 1024 * DIN; c.dst = (bf16_t*)(P.ws + WS_WIN); c.K = 1024; c.N = DIN; c.tile = it; }
    else if (it < CV_E1) { c.src = P.in[14] + (size_t)l * 1024 * 1024; c.dst = (bf16_t*)(P.ws + WS_WA); c.K = 1024; c.N = 1024; c.tile = it - CV_E0; }
    else if (it < CV_E2) { c.src = P.in[15] + (size_t)l * 1024 * 1024; c.dst = (bf16_t*)(P.ws + WS_WB); c.K = 1024; c.N = 1024; c.tile = it - CV_E1; }
    else if (it < CV_E3) { c.src = P.in[16] + (size_t)l * 1024 * 1024; c.dst = (bf16_t*)(P.ws + WS_WO); c.K = 1024; c.N = 1024; c.tile = it - CV_E2; }
    else if (it < CV_E4) { c.src = P.in[18] + (size_t)l * 1024 * 2 * DFF; c.dst = (bf16_t*)(P.ws + WS_WUP); c.K = 1024; c.N = 2 * DFF; c.tile = it - CV_E3; }
    else { c.src = P.in[21] + (size_t)l * DFF * 1024; c.dst = (bf16_t*)(P.ws + WS_WDN); c.K = DFF; c.N = 1024; c.tile = it - CV_E4; }
    return true;
}
DI void convert_weights(const Params& P, int l, unsigned char* lds, int sel = 0, int first_wg = 0) {
    unsigned short* T = (unsigned short*)lds;
    if ((int)blockIdx.x < first_wg) return;
    const int tid = ltid(), step = (int)gridDim.x - first_wg, kr = tid >> 4, nc = (tid & 15) * 4;
    int it = (int)blockIdx.x - first_wg; ConvItem cur{}, nxt{}; bool hc = false;
    while (it < CV_E5 && !(hc = conv_item(P, l, it, sel, cur))) it += step;
    float4 v0 = make_float4(0.f, 0.f, 0.f, 0.f), v1 = v0;
#define CV_FETCH(ci) do { const int ntn_ = (ci).N >> 6, tk_ = (ci).tile / ntn_, tn_ = (ci).tile - tk_ * ntn_; const float* s_ = (ci).src + (size_t)(tk_ * 64 + kr) * (ci).N + tn_ * 64 + nc; v0 = ntload4(s_); v1 = ntload4(s_ + (size_t)32 * (ci).N); } while (0)
    if (hc) CV_FETCH(cur);
    while (hc) {
        int itn = it + step; bool hn = false;
        while (itn < CV_E5 && !(hn = conv_item(P, l, itn, sel, nxt))) itn += step;
        T[(nc + 0) * 72 + kr] = f2bf(v0.x); T[(nc + 1) * 72 + kr] = f2bf(v0.y); T[(nc + 2) * 72 + kr] = f2bf(v0.z); T[(nc + 3) * 72 + kr] = f2bf(v0.w);
        T[(nc + 0) * 72 + kr + 32] = f2bf(v1.x); T[(nc + 1) * 72 + kr + 32] = f2bf(v1.y); T[(nc + 2) * 72 + kr + 32] = f2bf(v1.z); T[(nc + 3) * 72 + kr + 32] = f2bf(v1.w);
        __syncthreads();
        if (hn) CV_FETCH(nxt);
        { const int ntn = cur.N >> 6, tk = cur.tile / ntn, tn = cur.tile - tk * ntn, n = tid >> 3, kc = (tid & 7) * 8; const uint4 w = *(const uint4*)(T + n * 72 + kc); *(uint4*)(cur.dst + (size_t)(tn * 64 + n) * cur.K + tk * 64 + kc) = w; }
        __syncthreads();
        cur = nxt; it = itn; hc = hn;
    }
#undef CV_FETCH
    if (sel == 0 || sel == 4 || sel == 1) for (int t = (int)blockIdx.x - first_wg; t < CV_WS; t += step) { const float* sp = P.in[10] + (size_t)l * 8 * 128 * 128 + t * 4096; bf16_t* d = (bf16_t*)(P.ws + WS_WS) + t * 4096;
        for (int i = tid; i < 4096; i += 512) d[i] = f2bf(sp[i]); }
}

DI void phase_prologue(const Params& P, unsigned char* lds) {
    const int tid = ltid(), bid = blockIdx.x, G = gridDim.x;
    float* sl = (float*)lds; float* red = sl + 5 * 1024; float* modt = (float*)(P.ws + WS_MOD);
    bool have = false;
    for (int it = bid; it < 96; it += G) {
        if (!have) { for (int i = tid; i < 5 * 1024; i += 512) { const int m = i >> 10, k = i & 1023; const float c = m < 4 ? P.in[1][m * 1024 + k] : P.in[3][k]; sl[i] = c / (1.0f + expf(-c)); } __syncthreads(); have = true; }
        const int l = it / 48, cb = it - l * 48, col = cb * 128 + (tid & 127), kq = tid >> 7;
        const float* W = P.in[4] + (size_t)l * 1024 * 6144 + col;
        float a0 = 0.f, a1 = 0.f, a2 = 0.f, a3 = 0.f, a4 = 0.f;
#pragma unroll 16
        for (int k = kq * 256; k < kq * 256 + 256; ++k) { const float w = __builtin_nontemporal_load(W + (size_t)k * 6144); a0 += sl[k] * w; a1 += sl[1024 + k] * w; a2 += sl[2048 + k] * w; a3 += sl[3072 + k] * w; a4 += sl[4096 + k] * w; }
        float* rr = red + (kq * 5) * 128 + (tid & 127); rr[0] = a0; rr[128] = a1; rr[256] = a2; rr[384] = a3; rr[512] = a4;
        __syncthreads();
        if (tid < 128) { const float bias = P.in[5][l * 6144 + col];
#pragma unroll
            for (int m = 0; m < 5; ++m) modt[(l * 5 + m) * 6144 + col] = red[(0 * 5 + m) * 128 + tid] + red[(1 * 5 + m) * 128 + tid] + red[(2 * 5 + m) * 128 + tid] + red[(3 * 5 + m) * 128 + tid] + bias; }
        __syncthreads();
    }
    if (bid == G - 1) { float* lbt = (float*)(P.ws + WS_LB); for (int i = tid; i < 2048; i += 512) { const float h0 = P.in[12][i], h1 = P.in[12][2048 + i]; lbt[i] = 0.f; lbt[2048 + i] = 1.0f / (1.0f + expf(h0 - h1)); } }
    __syncthreads();
    convert_weights(P, 0, lds, 3, 96);
}

DI void norm_phase(const Params& P, int l, int which, bf16_t* dst, int nrows) {
    const bool from_in = (l == 0 && which == 0);
    const int tid_ = ltid(); const int lane = tid_ & 63, wid = tid_ >> 6;
    const float* nw = (which ? P.in[17] : P.in[6]) + l * 1024; const float* modt = (const float*)(P.ws + WS_MOD) + (size_t)l * 5 * 6144 + (which ? 3 : 0) * 1024;
    const int nw_tot = gridDim.x * 8;
    for (int rowb = blockIdx.x * 8 + wid; rowb < nrows; rowb += 2 * nw_tot) {
        float4 v[2][4]; int rows[2] = {rowb, rowb + nw_tot};
#pragma unroll
        for (int r = 0; r < 2; ++r) { const int row = rows[r] < nrows ? rows[r] : rowb;
            if (from_in) { const float4* xr = (const float4*)(row < RL ? P.in[0] + (size_t)row * 1024 : P.in[2] + (size_t)(row - RL) * 1024);
#pragma unroll
                for (int q = 0; q < 4; ++q) v[r][q] = ntload4((const float*)(xr + q * 64 + lane)); }
            else { const uint2* xr = (const uint2*)xrow16(P, row);
#pragma unroll
                for (int q = 0; q < 4; ++q) { const uint2 w = xr[q * 64 + lane]; v[r][q] = make_float4(bflo(w.x), bfhi(w.x), bflo(w.y), bfhi(w.y)); } } }
#pragma unroll
        for (int r = 0; r < 2; ++r) { const int row = rows[r]; if (row >= nrows) continue; float ss = 0.f;
#pragma unroll
            for (int q = 0; q < 4; ++q) ss += v[r][q].x * v[r][q].x + v[r][q].y * v[r][q].y + v[r][q].z * v[r][q].z + v[r][q].w * v[r][q].w;
            ss = wave_sum(ss); const float rstd = __builtin_amdgcn_rsqf(ss * (1.0f / 1024.0f) + 1e-6f);
            const int mi = row < RL ? (row >> 12) : 4; const float* sh = modt + mi * 6144; const float* sc = sh + 1024;
#pragma unroll
            for (int q = 0; q < 4; ++q) { const int col = 4 * (q * 64 + lane); const float4 w = *(const float4*)(nw + col), s = *(const float4*)(sc + col), h = *(const float4*)(sh + col);
                uint2 o; o.x = pk2(v[r][q].x * rstd * w.x * (1.f + s.x) + h.x, v[r][q].y * rstd * w.y * (1.f + s.y) + h.y); o.y = pk2(v[r][q].z * rstd * w.z * (1.f + s.z) + h.z, v[r][q].w * rstd * w.w * (1.f + s.w) + h.w);
                *(uint2*)(dst + (size_t)row * 1024 + col) = o; } }
    }
}

DI int scan_row0(int c, int b, int dir) { if (c < 4) { const int m = dir ? 3 - c : c; return RL + b * 256 + 64 * m; } const int n = c - 4, nn = dir ? 63 - n : n; return b * 4096 + 64 * nn; }
DI void scanprep_phase(const Params& P, unsigned char* lds, int l) {
    const int tid = ltid(), lane = tid & 63, to = tid >> 6, k0 = 2 * lane;
    float* tot = (float*)lds;
    const unsigned short* qh = slotp(P, 1); float* vec = (float*)(P.ws + WS_VEC);
    unsigned gr[8], qr[8];
#define PREP_LOAD(it) do { const int ch_ = (it) >> 4, hd_ = ((it) >> 1) & 7, dr_ = (it) & 1; unsigned vb_ = (unsigned)((ch_ * 64 + (dr_ ? 63 - 8 * to : 8 * to)) * 1024 + hd_ * 128 + k0); asm volatile("" : "+v"(vb_)); \
        const unsigned short* gb_ = slotp(P, dr_ ? 3 : 2); const int st_ = dr_ ? -1024 : 1024; \
        _Pragma("unroll") for (int j = 0; j < 8; ++j) { const unsigned o_ = vb_ + (unsigned)(j * st_); gr[j] = *(const unsigned*)(gb_ + o_); qr[j] = *(const unsigned*)(qh + o_); } } while (0)
    int item = blockIdx.x;
    if (item < 272 * 16) PREP_LOAD(item);
    for (; item < 272 * 16; item += gridDim.x) {
        const int chunk = item >> 4, hd = (item >> 1) & 7, dir = item & 1;
        float g0[8], g1[8]; float run0 = 0.f, run1 = 0.f; unsigned qc[8];
#pragma unroll
        for (int j = 0; j < 8; ++j) { g0[j] = h2f((unsigned short)(gr[j] & 0xffffu)); g1[j] = h2f((unsigned short)(gr[j] >> 16)); run0 += g0[j]; run1 += g1[j]; qc[j] = qr[j]; }
        if (item + (int)gridDim.x < 272 * 16) PREP_LOAD(item + (int)gridDim.x);
        *(float2*)(tot + to * 128 + k0) = make_float2(run0, run1);
        LBAR();
        float off0 = 0.f, off1 = 0.f, ref0 = 0.f, ref1 = 0.f, a0 = 0.f, a1 = 0.f;
#pragma unroll
        for (int o = 0; o < 8; ++o) { const float2 t = *(const float2*)(tot + o * 128 + k0); if (o == to) { off0 = a0; off1 = a1; } a0 += t.x; a1 += t.y; if (o == 3) { ref0 = a0; ref1 = a1; } }
        float bb0 = off0, bb1 = off1; unsigned qo[8], ko[8];
#pragma unroll
        for (int j = 0; j < 8; ++j) { bb0 += g0[j]; bb1 += g1[j];
            const float kk0 = 1.0f - __builtin_amdgcn_exp2f(g0[j]), kk1 = 1.0f - __builtin_amdgcn_exp2f(g1[j]);
            const float E0 = __builtin_amdgcn_exp2f(bb0 - ref0), E1 = __builtin_amdgcn_exp2f(bb1 - ref1), R0 = __builtin_amdgcn_rcpf(E0), R1 = __builtin_amdgcn_rcpf(E1);
            qo[j] = pk2(bflo(qc[j]) * E0, bfhi(qc[j]) * E1); ko[j] = pk2(kk0 * R0, kk1 * R1); }
        { unsigned vb_ = (unsigned)((chunk * 64 + (dir ? 63 - 8 * to : 8 * to)) * 1024 + hd * 128 + k0); asm volatile("" : "+v"(vb_));
            unsigned short* qb_ = slotp(P, dir ? 3 : 2); unsigned short* kb_ = slotp(P, 5 + dir); const int st_ = dir ? -1024 : 1024;
#pragma unroll
            for (int j = 0; j < 8; ++j) { const unsigned o_ = vb_ + (unsigned)(j * st_); *(unsigned*)(qb_ + o_) = qo[j]; *(unsigned*)(kb_ + o_) = ko[j]; } }
        if (to == 0) { float* vc = vec + (size_t)((chunk * 8 + hd) * 2 + dir) * 256; *(float2*)(vc + k0) = make_float2(__builtin_amdgcn_exp2f(ref0), __builtin_amdgcn_exp2f(ref1)); *(float2*)(vc + 128 + k0) = make_float2(__builtin_amdgcn_exp2f(a0 - ref0), __builtin_amdgcn_exp2f(a1 - ref1)); }
        LBAR();
    }
#undef PREP_LOAD
}
DI void scan_phase(const Params& P, unsigned char* lds, int l) {
    const int tid = ltid(), lane = tid & 63, wid = tid >> 6, fr = lane & 15, fq = lane >> 4;
    const int bid = blockIdx.x; if (bid >= 256) return;
    const int vq = bid >> 6, b = (bid >> 4) & 3, hd = (bid >> 1) & 7, dir = bid & 1;
    unsigned short* Qt = (unsigned short*)lds; unsigned short* Kt = Qt + 64 * 136; unsigned short* KtT = Kt + 64 * 136;
    unsigned short* VT = KtT + 128 * 72; unsigned short* Pm = VT + 32 * 72; unsigned short* ST = Pm + 64 * 72;
    const unsigned short* qi = slotp(P, dir ? 3 : 2); const unsigned short* kb = slotp(P, 5 + dir); const unsigned short* iv = slotp(P, 4); const float* vec = (const float*)(P.ws + WS_VEC);
    const unsigned opitch = dir ? 2048u : 1024u;
    const int to = wid, k0 = 2 * lane, cidx = hd * 128 + k0; const bool vmine = (lane >> 4) == vq;
    for (int i = tid; i < 32 * 136 / 2; i += 512) ((unsigned*)ST)[i] = 0u;
    f32x4 S[2];
    S[0] = (f32x4){0.f, 0.f, 0.f, 0.f}; S[1] = (f32x4){0.f, 0.f, 0.f, 0.f};
    unsigned qa_[8], ka_[8], va_[8], qb_r[8], kb_r[8], vb_r[8]; f32x4 era, ela, erb, elb;
    const unsigned vbase = (unsigned)((dir ? 63 - 8 * to : 8 * to) * 1024 + cidx); const int vstep = dir ? -1024 : 1024;
#define SCAN_LOAD(rb, Q_, K_, V_, E_, L_) do { unsigned vb_ = vbase; asm volatile("" : "+v"(vb_)); const unsigned short* qb_ = qi + (size_t)(rb) * 1024; const unsigned short* kb_ = kb + (size_t)(rb) * 1024; const unsigned short* ib_ = iv + (size_t)(rb) * 1024; \
        _Pragma("unroll") for (int j = 0; j < 8; ++j) { const unsigned o_ = vb_ + (unsigned)(j * vstep); Q_[j] = *(const unsigned*)(qb_ + o_); K_[j] = *(const unsigned*)(kb_ + o_); if (vmine) V_[j] = *(const unsigned*)(ib_ + o_); } \
        const float* vc_ = vec + (size_t)(((rb) >> 6) * 8 + hd) * 2 * 256 + dir * 256 + 16 * wid + 4 * fq; E_ = *(const f32x4*)vc_; L_ = *(const f32x4*)(vc_ + 128); } while (0)
#define SCAN_ITER(CC, QR, KR, VR, ER, EL, ERN) do { \
        const int row0 = scan_row0(CC, b, dir); const f32x4 erc = ER, elc = EL; \
        _Pragma("unroll") for (int j = 0; j < 8; ++j) { const int tau = 8 * to + j; *(unsigned*)(Qt + tau * 136 + k0) = QR[j]; *(unsigned*)(Kt + tau * 136 + k0) = KR[j]; } \
        { uint4 w; w.x = (KR[0] & 0xffffu) | (KR[1] << 16); w.y = (KR[2] & 0xffffu) | (KR[3] << 16); w.z = (KR[4] & 0xffffu) | (KR[5] << 16); w.w = (KR[6] & 0xffffu) | (KR[7] << 16); *(uint4*)(KtT + k0 * 72 + 8 * to) = w; \
            w.x = (KR[0] >> 16) | (KR[1] & 0xffff0000u); w.y = (KR[2] >> 16) | (KR[3] & 0xffff0000u); w.z = (KR[4] >> 16) | (KR[5] & 0xffff0000u); w.w = (KR[6] >> 16) | (KR[7] & 0xffff0000u); *(uint4*)(KtT + (k0 + 1) * 72 + 8 * to) = w; } \
        if (vmine) { const int vl = k0 & 31; uint4 w; w.x = (VR[0] & 0xffffu) | (VR[1] << 16); w.y = (VR[2] & 0xffffu) | (VR[3] << 16); w.z = (VR[4] & 0xffffu) | (VR[5] << 16); w.w = (VR[6] & 0xffffu) | (VR[7] << 16); *(uint4*)(VT + vl * 72 + 8 * to) = w; \
            w.x = (VR[0] >> 16) | (VR[1] & 0xffff0000u); w.y = (VR[2] >> 16) | (VR[3] & 0xffff0000u); w.z = (VR[4] >> 16) | (VR[5] & 0xffff0000u); w.w = (VR[6] >> 16) | (VR[7] & 0xffff0000u); *(uint4*)(VT + (vl + 1) * 72 + 8 * to) = w; } \
        if ((CC) + 2 < 68) { SCAN_LOAD(scan_row0((CC) + 2, b, dir), QR, KR, VR, ER, EL); } \
        LBAR(); \
        const bool live_ = !(l == 1 && (CC) < 4);                                    \
        if (live_) { const int ti = wid >> 1; \
            _Pragma("unroll") for (int e = 0; e < 2; ++e) { const int si = 2 * (wid & 1) + e; f32x4 acc = (f32x4){0.f, 0.f, 0.f, 0.f}; \
                if (si <= ti) { \
                    _Pragma("unroll") for (int ks = 0; ks < 4; ++ks) { const bf16x8 a = *(const bf16x8*)(Qt + (16 * ti + fr) * 136 + 32 * ks + 8 * fq); const bf16x8 bq = *(const bf16x8*)(Kt + (16 * si + fr) * 136 + 32 * ks + 8 * fq); acc = MFMA16(bq, a, acc); } } \
                const int t = 16 * ti + fr, s0 = 16 * si + 4 * fq; uint2 w; w.x = pk2(s0 <= t ? acc[0] : 0.f, s0 + 1 <= t ? acc[1] : 0.f); w.y = pk2(s0 + 2 <= t ? acc[2] : 0.f, s0 + 3 <= t ? acc[3] : 0.f); \
                *(uint2*)(Pm + t * 72 + s0) = w; } } \
        LBAR(); \
        if (live_) { const int tt = wid & 3, vtl = wid >> 2; f32x4 acc = (f32x4){0.f, 0.f, 0.f, 0.f}; \
            unsigned ob_ = (unsigned)(dir ? 63 - (16 * tt + fr) : 16 * tt + fr) * opitch + (unsigned)(hd * 128 + 32 * vq + 16 * vtl + 4 * fq); asm volatile("" : "+v"(ob_)); \
            unsigned short* oo = dir ? xrow16(P, row0) + 1024 : slotp(P, 1) + (size_t)row0 * 1024; \
            _Pragma("unroll") for (int ks = 0; ks < 2; ++ks) acc = MFMA16(*(const bf16x8*)(VT + (16 * vtl + fr) * 72 + 32 * ks + 8 * fq), *(const bf16x8*)(Pm + (16 * tt + fr) * 72 + 32 * ks + 8 * fq), acc); \
            _Pragma("unroll") for (int ks = 0; ks < 4; ++ks) acc = MFMA16(*(const bf16x8*)(ST + (16 * vtl + fr) * 136 + 32 * ks + 8 * fq), *(const bf16x8*)(Qt + (16 * tt + fr) * 136 + 32 * ks + 8 * fq), acc); \
            uint2 w; w.x = pk2(acc[0], acc[1]); w.y = pk2(acc[2], acc[3]); *(uint2*)(oo + ob_) = w; } \
        { bf16x8 ka[2]; \
            _Pragma("unroll") for (int ks = 0; ks < 2; ++ks) ka[ks] = *(const bf16x8*)(KtT + (16 * wid + fr) * 72 + 32 * ks + 8 * fq); \
            const f32x4 dc4 = erc * elc; \
            _Pragma("unroll") for (int vt = 0; vt < 2; ++vt) { f32x4 T = (f32x4){0.f, 0.f, 0.f, 0.f}; \
                _Pragma("unroll") for (int ks = 0; ks < 2; ++ks) T = MFMA16(ka[ks], *(const bf16x8*)(VT + (16 * vt + fr) * 72 + 32 * ks + 8 * fq), T); \
                S[vt] = dc4 * S[vt] + elc * T; } } \
        LBAR(); \
        _Pragma("unroll") for (int vt = 0; vt < 2; ++vt) { const f32x4 sv = S[vt] * ERN; uint2 w; w.x = pk2(sv[0], sv[1]); w.y = pk2(sv[2], sv[3]); *(uint2*)(ST + (16 * vt + fr) * 136 + 16 * wid + 4 * fq) = w; } \
    } while (0)
    SCAN_LOAD(scan_row0(0, b, dir), qa_, ka_, va_, era, ela);
    SCAN_LOAD(scan_row0(1, b, dir), qb_r, kb_r, vb_r, erb, elb);
    __syncthreads();
    for (int c = 0; c < 68; c += 2) {
        SCAN_ITER(c, qa_, ka_, va_, era, ela, erb);
        SCAN_ITER(c + 1, qb_r, kb_r, vb_r, erb, elb, era);
    }
#undef SCAN_ITER
}
#undef SCAN_LOAD
DI void readout_phase(const Params& P, int l, int nrows, int dry, int s_of, int s_ob, int s_og) {
    const int tid_ = ltid(); const int lane = tid_ & 63, wid = tid_ >> 6;
    bf16_t* of = slotp(P, s_of); const bf16_t* og = slotp(P, s_og); const float* nw = P.in[13] + l * 128 + 16 * (lane & 7);
    for (int row = blockIdx.x * 8 + wid; row < nrows; row += gridDim.x * 8) {
        const size_t off = (size_t)row * 1024 + 16 * lane; float o[16], g[16]; const bf16_t* obr = xrow16(P, row) + 1024 + 16 * lane;
#pragma unroll
        for (int h = 0; h < 2; ++h) { const uint4 a = *(const uint4*)(of + off + 8 * h), bb = *(const uint4*)(obr + 8 * h), gg = *(const uint4*)(og + off + 8 * h);
            o[8 * h + 0] = bflo(a.x) + bflo(bb.x); o[8 * h + 1] = bfhi(a.x) + bfhi(bb.x); o[8 * h + 2] = bflo(a.y) + bflo(bb.y); o[8 * h + 3] = bfhi(a.y) + bfhi(bb.y);
            o[8 * h + 4] = bflo(a.z) + bflo(bb.z); o[8 * h + 5] = bfhi(a.z) + bfhi(bb.z); o[8 * h + 6] = bflo(a.w) + bflo(bb.w); o[8 * h + 7] = bfhi(a.w) + bfhi(bb.w);
            g[8 * h + 0] = bflo(gg.x); g[8 * h + 1] = bfhi(gg.x); g[8 * h + 2] = bflo(gg.y); g[8 * h + 3] = bfhi(gg.y); g[8 * h + 4] = bflo(gg.z); g[8 * h + 5] = bfhi(gg.z); g[8 * h + 6] = bflo(gg.w); g[8 * h + 7] = bfhi(gg.w); }
        float ss = 0.f;
#pragma unroll
        for (int j = 0; j < 16; ++j) ss += o[j] * o[j];
        ss += __shfl_xor(ss, 1); ss += __shfl_xor(ss, 2); ss += __shfl_xor(ss, 4);
        const float rstd = __builtin_amdgcn_rsqf(ss * (1.0f / 128.0f) + 1e-6f);
        float y[16];
#pragma unroll
        for (int j = 0; j < 16; ++j) y[j] = o[j] * rstd * nw[j] * g[j];
#pragma unroll
        for (int h = 0; h < 2; ++h) { uint4 w; w.x = pk2(y[8 * h], y[8 * h + 1]); w.y = pk2(y[8 * h + 2], y[8 * h + 3]); w.z = pk2(y[8 * h + 4], y[8 * h + 5]); w.w = pk2(y[8 * h + 6], y[8 * h + 7]); *(uint4*)((dry ? slotp(P, 6) : of) + off + 8 * h) = w; }
    }
}

DI void sgu_phase(const Params& P, unsigned char* lds, int l, int nrows, int dry, int s_u, int s_v) {
    const int tid = ltid(), lane = tid & 63, wid = tid >> 6, fr = lane & 15, fq = lane >> 4;
    float* stat = (float*)lds; unsigned short* vnT = (unsigned short*)(lds + 1024);
    bf16_t* up = slotp(P, s_u); const bf16_t* vp = slotp(P, s_v); const float* lnw = P.in[8] + l * 1024; const float* lnb = P.in[9] + l * 1024;
    const bf16_t* Ws = (const bf16_t*)(P.ws + WS_WS); const float* bs = P.in[11] + l * 1024;
    bf16_t* yout = dry ? slotp(P, 6) : up; const int nitems = (nrows / 128) * 8;
    const int s_ = tid >> 2, dq = (tid & 3) * 32;
    uint4 vr0, vr1, vr2, vr3; float4 sq[8];
#define SGU_FETCH(it) do { const int r0_ = ((it) >> 3) * 128, g_ = (it) & 7; const bf16_t* vs_ = vp + (size_t)(r0_ + s_) * 1024 + g_ * 128 + dq; vr0 = *(const uint4*)vs_; vr1 = *(const uint4*)(vs_ + 8); vr2 = *(const uint4*)(vs_ + 16); vr3 = *(const uint4*)(vs_ + 24); \
        if (tid < 128) { const float4* sp_ = (const float4*)((const float*)(P.ws + WS_VEC) + (size_t)(r0_ + tid) * 32); _Pragma("unroll") for (int i = 0; i < 8; ++i) sq[i] = sp_[i]; } } while (0)
    int item = blockIdx.x;
    if (item < nitems) SGU_FETCH(item);
    for (; item < nitems; item += gridDim.x) {
        const int r0 = (item >> 3) * 128, g = item & 7, t = 16 * wid + fr;
        bf16x8 a[4]; uint2 uu[8];
#pragma unroll
        for (int ks = 0; ks < 4; ++ks) a[ks] = *(const bf16x8*)(Ws + g * 16384 + (16 * wid + fr) * 128 + 32 * ks + 8 * fq);
#pragma unroll
        for (int dt = 0; dt < 8; ++dt) uu[dt] = *(const uint2*)(up + (size_t)(r0 + t) * 1024 + g * 128 + 16 * dt + 4 * fq);
        const float bt = bs[g * 128 + t];
        if (tid < 128) { float t1 = 0.f, t2 = 0.f;
#pragma unroll
            for (int i = 0; i < 8; ++i) { t1 += sq[i].x; t2 += sq[i].y; t1 += sq[i].z; t2 += sq[i].w; }
            const float mean = t1 * (1.0f / 1024.0f); const float var = t2 * (1.0f / 1024.0f) - mean * mean;
            stat[2 * tid] = mean; stat[2 * tid + 1] = __builtin_amdgcn_rsqf(fmaxf(var, 0.f) + 1e-5f); }
        __syncthreads();
        { const float mean = stat[2 * s_], rstd = stat[2 * s_ + 1]; const unsigned ww[16] = {vr0.x, vr0.y, vr0.z, vr0.w, vr1.x, vr1.y, vr1.z, vr1.w, vr2.x, vr2.y, vr2.z, vr2.w, vr3.x, vr3.y, vr3.z, vr3.w};
#pragma unroll
            for (int e = 0; e < 32; ++e) { const int d = dq + e, ch = g * 128 + d; const float x = (e & 1) ? bfhi(ww[e >> 1]) : bflo(ww[e >> 1]);
                vnT[d * 136 + (s_ ^ ((tid & 3) << 4))] = f2bf((x - mean) * rstd * lnw[ch] + lnb[ch]); } }
        __syncthreads();
        if (item + (int)gridDim.x < nitems) SGU_FETCH(item + (int)gridDim.x);
#pragma unroll
        for (int dt = 0; dt < 8; ++dt) { f32x4 acc = (f32x4){0.f, 0.f, 0.f, 0.f};
#pragma unroll
            for (int ks = 0; ks < 4; ++ks) acc = MFMA16(*(const bf16x8*)(vnT + (16 * dt + fr) * 136 + ((32 * ks + 8 * fq) ^ (((dt >> 1) & 3) << 4))), a[ks], acc);
            const size_t off = (size_t)(r0 + t) * 1024 + g * 128 + 16 * dt + 4 * fq; uint2 w;
            w.x = pk2(bflo(uu[dt].x) * (acc[0] + bt), bfhi(uu[dt].x) * (acc[1] + bt)); w.y = pk2(bflo(uu[dt].y) * (acc[2] + bt), bfhi(uu[dt].y) * (acc[3] + bt)); *(uint2*)(yout + off) = w; }
        __syncthreads();
    }
#undef SGU_FETCH
}

DI void conv_phase(const Params& P, int l, int nrows, int dry) {
    const bf16_t* a = (const bf16_t*)(P.ws + WS_ACT); bf16_t* v2 = (bf16_t*)(P.ws + WS_ACT) + (size_t)RT * DFF;
    const float* cw = P.in[19] + (size_t)l * 9 * DFF; const float* cb = P.in[20] + (size_t)l * DFF;
    const int tid0 = blockIdx.x * 512 + ltid();
    for (int idx = tid0; idx < NBATCH * 64 * 4 * (DFF / 8); idx += gridDim.x * 512) {
        const int c8 = idx % (DFF / 8), r = idx / (DFF / 8), seg = r & 3, gy = (r >> 2) & 63, b = r >> 8, c = c8 * 8, gx0 = seg * 16, rb = b * 4096 + gy * 64;
        float w[9][8], bias[8], win[3][3][8];
#pragma unroll
        for (int t = 0; t < 9; ++t) { const float4 w0 = *(const float4*)(cw + t * DFF + c), w1 = *(const float4*)(cw + t * DFF + c + 4); w[t][0] = w0.x; w[t][1] = w0.y; w[t][2] = w0.z; w[t][3] = w0.w; w[t][4] = w1.x; w[t][5] = w1.y; w[t][6] = w1.z; w[t][7] = w1.w; }
        { const float4 b0 = *(const float4*)(cb + c), b1 = *(const float4*)(cb + c + 4); bias[0] = b0.x; bias[1] = b0.y; bias[2] = b0.z; bias[3] = b0.w; bias[4] = b1.x; bias[5] = b1.y; bias[6] = b1.z; bias[7] = b1.w; }
#define CONV_FETCH(gx) do { _Pragma("unroll") for (int dy = 0; dy < 3; ++dy) { const int yy = gy + dy - 1; const bool ok = (unsigned)yy < 64u && (unsigned)(gx) < 64u; \
            const int rr_ = ok ? rb + (dy - 1) * 64 + (gx) : rb; pf[dy] = *(const uint4*)(a + (size_t)rr_ * DFF + c); if (!ok) pf[dy] = make_uint4(0u, 0u, 0u, 0u); } } while (0)
#define CONV_UNPACK(slot) do { _Pragma("unroll") for (int dy = 0; dy < 3; ++dy) { const uint4 av = pf[dy]; \
            win[dy][slot][0] = bflo(av.x); win[dy][slot][1] = bfhi(av.x); win[dy][slot][2] = bflo(av.y); win[dy][slot][3] = bfhi(av.y); win[dy][slot][4] = bflo(av.z); win[dy][slot][5] = bfhi(av.z); win[dy][slot][6] = bflo(av.w); win[dy][slot][7] = bfhi(av.w); } } while (0)
        uint4 pf[3]; uint4 vvn;
        CONV_FETCH(gx0 - 1); CONV_UNPACK(0); CONV_FETCH(gx0); CONV_UNPACK(1);
        CONV_FETCH(gx0 + 1); vvn = *(const uint4*)(v2 + (size_t)(rb + gx0) * DFF + c);
#pragma unroll
        for (int st = 0; st < 16; ++st) { const int gx = gx0 + st; const int s0 = st % 3, s1 = (st + 1) % 3, s2 = (st + 2) % 3;
            CONV_UNPACK(s2); const uint4 vv = vvn;
            if (st < 15) { CONV_FETCH(gx + 2); vvn = *(const uint4*)(v2 + (size_t)(rb + gx + 1) * DFF + c); }
            float acc[8];
#pragma unroll
            for (int j = 0; j < 8; ++j) { float t = bias[j];
#pragma unroll
                for (int dy = 0; dy < 3; ++dy) t += win[dy][s0][j] * w[dy * 3][j] + win[dy][s1][j] * w[dy * 3 + 1][j] + win[dy][s2][j] * w[dy * 3 + 2][j];
                acc[j] = t; }
            const size_t off = (size_t)(rb + gx) * DFF + c; uint4 o;
            o.x = pk2(gelu_t(acc[0]) * bflo(vv.x), gelu_t(acc[1]) * bfhi(vv.x)); o.y = pk2(gelu_t(acc[2]) * bflo(vv.y), gelu_t(acc[3]) * bfhi(vv.y));
            o.z = pk2(gelu_t(acc[4]) * bflo(vv.z), gelu_t(acc[5]) * bfhi(vv.z)); o.w = pk2(gelu_t(acc[6]) * bflo(vv.w), gelu_t(acc[7]) * bfhi(vv.w));
            *(uint4*)(dry ? (bf16_t*)(P.ws + WS_ACT) + (size_t)RT * DFF * 2 + (off & 0xFFFFF8) : v2 + off) = o; }
#undef CONV_FETCH
#undef CONV_UNPACK
    }
    for (int idx = tid0; idx < (nrows - RL) * (DFF / 8); idx += gridDim.x * 512) {
        const int row = RL + idx / (DFF / 8), c = (idx % (DFF / 8)) * 8, t = (row - RL) & 255;
        float acc[8]; { const float4 b0 = *(const float4*)(cb + c), b1 = *(const float4*)(cb + c + 4); acc[0] = b0.x; acc[1] = b0.y; acc[2] = b0.z; acc[3] = b0.w; acc[4] = b1.x; acc[5] = b1.y; acc[6] = b1.z; acc[7] = b1.w; }
        for (int dx = -1; dx <= 1; ++dx) { if ((unsigned)(t + dx) >= 256u) continue;
            const uint4 av = *(const uint4*)(a + (size_t)(row + dx) * DFF + c); const float4 w0 = *(const float4*)(cw + (4 + dx) * DFF + c), w1 = *(const float4*)(cw + (4 + dx) * DFF + c + 4);
            acc[0] += bflo(av.x) * w0.x; acc[1] += bfhi(av.x) * w0.y; acc[2] += bflo(av.y) * w0.z; acc[3] += bfhi(av.y) * w0.w; acc[4] += bflo(av.z) * w1.x; acc[5] += bfhi(av.z) * w1.y; acc[6] += bflo(av.w) * w1.z; acc[7] += bfhi(av.w) * w1.w; }
        const size_t off = (size_t)row * DFF + c; const uint4 vv = *(const uint4*)(v2 + off); uint4 o;
        o.x = pk2(gelu_t(acc[0]) * bflo(vv.x), gelu_t(acc[1]) * bfhi(vv.x)); o.y = pk2(gelu_t(acc[2]) * bflo(vv.y), gelu_t(acc[3]) * bfhi(vv.y));
        o.z = pk2(gelu_t(acc[4]) * bflo(vv.z), gelu_t(acc[5]) * bfhi(vv.z)); o.w = pk2(gelu_t(acc[6]) * bflo(vv.w), gelu_t(acc[7]) * bfhi(vv.w));
        *(uint4*)(dry ? (bf16_t*)(P.ws + WS_ACT) + (size_t)RT * DFF * 2 + (off & 0xFFFFF8) : v2 + off) = o;
    }
}

DI void final_phase(const Params& P, int dry) {
    const int tid_ = ltid(); const int lane = tid_ & 63, wid = tid_ >> 6; const float* fw = P.in[22]; const int nw_tot = gridDim.x * 8;
    for (int rowb = blockIdx.x * 8 + wid; rowb < RL; rowb += 2 * nw_tot) {
        float4 v[2][4]; const int rows[2] = {rowb, rowb + nw_tot};
#pragma unroll
        for (int r = 0; r < 2; ++r) { const int row = rows[r] < RL ? rows[r] : rowb; const uint2* xb = (const uint2*)((const bf16_t*)P.out + (size_t)row * 2048);
#pragma unroll
            for (int q = 0; q < 4; ++q) { const uint2 w = xb[q * 64 + lane]; v[r][q] = make_float4(bflo(w.x), bfhi(w.x), bflo(w.y), bfhi(w.y)); } }
        asm volatile("s_waitcnt vmcnt(0)" ::: "memory");
#pragma unroll
        for (int r = 0; r < 2; ++r) { const int row = rows[r]; if (row >= RL) continue; float4* xr = (float4*)(P.out + (size_t)row * 1024); float ss = 0.f;
#pragma unroll
            for (int q = 0; q < 4; ++q) ss += v[r][q].x * v[r][q].x + v[r][q].y * v[r][q].y + v[r][q].z * v[r][q].z + v[r][q].w * v[r][q].w;
            ss = wave_sum(ss); const float rstd = __builtin_amdgcn_rsqf(ss * (1.0f / 1024.0f) + 1e-6f);
#pragma unroll
            for (int q = 0; q < 4; ++q) { const float4 w = *(const float4*)(fw + 4 * (q * 64 + lane)); float4 o; o.x = v[r][q].x * rstd * w.x; o.y = v[r][q].y * rstd * w.y; o.z = v[r][q].z * rstd * w.z; o.w = v[r][q].w * rstd * w.w; if (!dry) xr[q * 64 + lane] = o; } }
    }
}

constexpr int N_PHASES = 26;
#ifndef PROBE_MASK
#define PROBE_MASK 0
#endif
#define PR(n) (((PROBE_MASK) >> (n)) & 1)
__global__ void __launch_bounds__(512) mega_fwd(Params P) {
    extern __shared__ __attribute__((aligned(16))) unsigned char lds[];
    cg::grid_group grid = cg::this_grid();
#define IN(k) (P.ph_lo <= (k) && (k) < P.ph_hi)
#define SEAM(k) do { if (IN(k) && IN((k) + 1)) { xcd_barrier(xb); if constexpr (PR(15)) xcd_barrier(xb); } } while (0)
    volatile LAS3 unsigned* st_words = (volatile LAS3 unsigned*)((LAS3 unsigned char*)lds + (LDS_BYTES - 16));
    if (threadIdx.x < 4) st_words[threadIdx.x] = 0u;
    __syncthreads();
    unsigned* barw = (unsigned*)(P.ws + WS_BAR);
    if (IN(0)) { if constexpr (PR(12)) { phase_prologue(P, lds); __syncthreads(); } phase_prologue(P, lds); }
    if (P.ph_lo < 0) grid.sync();
    XcdBarrier xb = xcd_barrier_post(barw, st_words);
    SEAM(0);
    const bf16_t* WinT = (const bf16_t*)(P.ws + WS_WIN);
    for (int l = 0; l < 2; ++l) {
        const int base = 1 + 12 * l; const int MP = (l == 1) ? RL : RT; const float* modl = (const float*)(P.ws + WS_MOD) + (size_t)l * 5 * 6144;
        if (IN(base + 0)) { norm_phase(P, l, 0, slotp(P, 0), RT); }
        SEAM(base + 0);
        if (IN(base + 1)) { Epi<M_H> E{}; E.o0 = slotp(P, 1); E.o1 = slotp(P, 2); E.o2 = slotp(P, 3); E.o3 = slotp(P, 4); E.gate = (const float*)(P.ws + WS_LB) + l * 2048; if constexpr (PR(1)) run_gemm<M_H>(lds, slotp(P, 0), WinT, RT, 4096, 1024, E); run_gemm<M_H>(lds, slotp(P, 0), WinT, RT, 4096, 1024, E);
            __syncthreads(); convert_weights(P, l, lds, 4, 64); }
        SEAM(base + 1);
        if (IN(base + 2)) scanprep_phase(P, lds, l);
        SEAM(base + 2);
        if (IN(base + 3)) scan_phase(P, lds, l);
        SEAM(base + 3);
        if (IN(base + 4)) { Epi<M_B> E{}; E.o0 = slotp(P, 3); E.o1 = slotp(P, 4); E.o2 = slotp(P, 5); E.o3 = slotp(P, 6); E.gate = (const float*)(P.ws + WS_VEC);
            if constexpr (PR(3)) run_gemm<M_B>(lds, slotp(P, 0), WinT + (size_t)4096 * 1024, MP, 5120, 1024, E); run_gemm<M_B>(lds, slotp(P, 0), WinT + (size_t)4096 * 1024, MP, 5120, 1024, E); }
        SEAM(base + 4);
        if (IN(base + 5)) { if constexpr (PR(4)) { readout_phase(P, l, MP, 1, 1, 0, 5); sgu_phase(P, lds, l, MP, 1, 3, 4); } if (blockIdx.x & 8) { sgu_phase(P, lds, l, MP, 0, 3, 4); readout_phase(P, l, MP, 0, 1, 0, 5); } else { readout_phase(P, l, MP, 0, 1, 0, 5); sgu_phase(P, lds, l, MP, 0, 3, 4); } }
        SEAM(base + 5);
        if (IN(base + 6)) {
            const bool early_ = (blockIdx.x & 8) != 0;
            if (l == 0 && early_) { ctx_ab_gemm(P, lds); __syncthreads(); convert_weights(P, 1, lds, 3, 0); __syncthreads(); }
            { Epi<M_WA> E{}; E.o0 = slotp(P, 5); E.g0 = slotp(P, 6); if constexpr (PR(6)) run_gemm<M_WA>(lds, slotp(P, 3), (const bf16_t*)(P.ws + WS_WA), MP, 1024, 1024, E); run_gemm<M_WA>(lds, slotp(P, 3), (const bf16_t*)(P.ws + WS_WA), RL, 1024, 1024, E); }
            { Epi<M_WB> E{}; E.o0 = slotp(P, 2); E.g0 = (const bf16_t*)((const unsigned char*)slotp(P, 6) + 1024); E.g1 = slotp(P, 5); if constexpr (PR(6)) run_gemm<M_WB>(lds, slotp(P, 1), (const bf16_t*)(P.ws + WS_WB), MP, 1024, 1024, E); run_gemm<M_WB>(lds, slotp(P, 1), (const bf16_t*)(P.ws + WS_WB), RL, 1024, 1024, E); }
            if (l == 0 && !early_) { ctx_ab_gemm(P, lds); __syncthreads(); convert_weights(P, 1, lds, 3, 0); }
        }
        SEAM(base + 6);
        if (IN(base + 7)) { Epi<M_RES> E{}; E.xl = P.out; E.xc = (float*)(P.ws + WS_CTX); E.gate = modl + 2 * 1024; E.sl = l == 0 ? P.in[0] : nullptr; E.sc = l == 0 ? P.in[2] : nullptr; run_gemm<M_RES>(lds, slotp(P, 2), (const bf16_t*)(P.ws + WS_WO), RL, 1024, 1024, E);
            if (l == 0) ctx_res_gemm(P, lds, slotp(P, 2) + (size_t)RL * 1024, 1024, (const bf16_t*)(P.ws + WS_WO), 1024, modl + 4 * 6144 + 2 * 1024, P.in[2]); }
        SEAM(base + 7);
        if (IN(base + 8)) { if constexpr (PR(8)) norm_phase(P, l, 1, slotp(P, 6), MP); norm_phase(P, l, 1, slotp(P, 6), MP); }
        SEAM(base + 8);
        if (IN(base + 9)) { Epi<M_UP> E{}; E.o0 = (bf16_t*)(P.ws + WS_ACT); E.o1 = (bf16_t*)(P.ws + WS_ACT) + (size_t)RT * DFF; if constexpr (PR(9)) run_gemm<M_UP>(lds, slotp(P, 6), (const bf16_t*)(P.ws + WS_WUP), MP, 2 * DFF, 1024, E); run_gemm<M_UP>(lds, slotp(P, 6), (const bf16_t*)(P.ws + WS_WUP), MP, 2 * DFF, 1024, E); }
        SEAM(base + 9);
        if (IN(base + 10)) { if constexpr (PR(10)) conv_phase(P, l, MP, 1); conv_phase(P, l, MP, 0); }
        SEAM(base + 10);
        if (IN(base + 11)) { Epi<M_RES> E{}; E.xl = P.out; E.xc = (float*)(P.ws + WS_CTX); E.gate = modl + 5 * 1024; E.sl = nullptr; E.sc = nullptr; run_gemm<M_RES>(lds, (const bf16_t*)(P.ws + WS_ACT) + (size_t)RT * DFF, (const bf16_t*)(P.ws + WS_WDN), RL, 1024, DFF, E);
            if (l == 0) { ctx_res_gemm(P, lds, (const bf16_t*)(P.ws + WS_ACT) + (size_t)RT * DFF + (size_t)RL * DFF, DFF, (const bf16_t*)(P.ws + WS_WDN), DFF, modl + 4 * 6144 + 5 * 1024, nullptr); } }
        SEAM(base + 11);
    }
    if (IN(25)) final_phase(P, 0);
#undef IN
#undef SEAM
}

#ifndef MULTI_LAUNCH
#define MULTI_LAUNCH 0
#endif
extern "C" void kernel_launch(void* const* d_in, const int* in_sizes, int n_in, void* d_out, int out_size, void* d_ws, size_t ws_size, hipStream_t stream) {
    static int grid = 0;
    if (grid == 0) {
        if (n_in != 23 || out_size != RL * 1024 || ws_size < WS_END) { fprintf(stderr, "kernel_launch: unexpected problem (n_in %d out %d ws %zu need %zu)\n", n_in, out_size, ws_size, (size_t)WS_END); grid = -1; return; }
        int dev = 0, cus = 0, per_cu = 0;
        hipGetDevice(&dev); hipDeviceGetAttribute(&cus, hipDeviceAttributeMultiprocessorCount, dev);
        if (hipFuncSetAttribute((const void*)mega_fwd, hipFuncAttributeMaxDynamicSharedMemorySize, LDS_BYTES) != hipSuccess) { fprintf(stderr, "kernel_launch: hipFuncSetAttribute failed\n"); grid = -1; return; }
        if (hipOccupancyMaxActiveBlocksPerMultiprocessor(&per_cu, (const void*)mega_fwd, 512, LDS_BYTES) != hipSuccess || per_cu < 1) { fprintf(stderr, "kernel_launch: occupancy query says %d blocks per CU\n", per_cu); (void)hipGetLastError(); per_cu = 1; }
        grid = cus;
        if (grid < 256) { fprintf(stderr, "kernel_launch: needs 256 CUs\n"); grid = -1; return; } grid = 256;
    }
    if (grid < 0) return;
    Params p{};
    for (int i = 0; i < 23; ++i) p.in[i] = (const float*)d_in[i];
    p.out = (float*)d_out; p.ws = (unsigned char*)d_ws;
#if MULTI_LAUNCH
    for (int k = 0; k < N_PHASES; ++k) { p.ph_lo = k; p.ph_hi = k + 1; hipLaunchKernelGGL(mega_fwd, dim3(grid), dim3(512), LDS_BYTES, stream, p); }
#else
    p.ph_lo = 0; p.ph_hi = N_PHASES;
    if (hipMemsetAsync((char*)d_ws + WS_BAR, 0, XCD_BAR_WORDS * 4, stream) != hipSuccess) { fprintf(stderr, "kernel_launch: memset of the barrier words failed\n"); return; }
    void* args[] = {&p};
    hipError_t e = hipLaunchCooperativeKernel((const void*)mega_fwd, dim3(grid), dim3(512), args, LDS_BYTES, stream);
    if (e != hipSuccess) fprintf(stderr, "cooperative launch failed: %s (grid %d)\n", hipGetErrorString(e), grid);
#endif
}
```
